# Optimizing an MI355X kernel written in HIP

```python
import math
import jax, jax.numpy as jnp
from jax import lax
import numpy as np

D_MODEL = 1024
BATCH = 8
SEQ = 4096
DEPTH = 1

PLE_DIM = 256
EPS = 1e-6
SSD_HEADS = 16
SSD_HEAD_DIM = 64
SSD_INNER = SSD_HEADS * SSD_HEAD_DIM
SSD_GROUPS = 2
SSD_STATE = 64
SSD_CONV = 4
SSD_CHUNK = 128
SSD_CONV_CH = SSD_INNER + 2 * SSD_GROUPS * SSD_STATE
ATT_HEADS = 16
ATT_HEAD_DIM = 64
ATT_INNER = ATT_HEADS * ATT_HEAD_DIM
MOBA_BLOCK = 256
MOBA_TOPK = 3
MOBA_QCHUNK = 16
ROPE_THETA = 10000.0
IN_SPLITS = (SSD_INNER, SSD_CONV_CH, SSD_HEADS, ATT_INNER, ATT_INNER, ATT_INNER, D_MODEL, D_MODEL)
IN_WIDTH = 7440
N_GROUPS = 4
EXPERTS_PER_GROUP = 8
TOPK_IN_GROUP = 2
D_EXPERT = 256

kernel_name = "hybrid_ssd_moba_hiermoe_block"


def rms_norm(x, w):
    xf = x.astype(jnp.float32)
    inv = lax.rsqrt(jnp.mean(xf * xf, axis=-1, keepdims=True) + EPS)
    return (xf * inv).astype(x.dtype) * w


def split_columns(proj):
    offs = np.cumsum(IN_SPLITS)[:-1].tolist()
    return jnp.split(proj, offs, axis=-1)


def rope(x, positions):
    half = x.shape[-1] // 2
    inv_freq = ROPE_THETA ** (-jnp.arange(half, dtype=jnp.float32) / half)
    ang = positions.astype(jnp.float32)[..., None] * inv_freq
    cos = jnp.cos(ang)[:, :, None, :].astype(x.dtype)
    sin = jnp.sin(ang)[:, :, None, :].astype(x.dtype)
    x1, x2 = x[..., :half], x[..., half:]
    return jnp.concatenate([x1 * cos - x2 * sin, x2 * cos + x1 * sin], axis=-1)


def causal_dwconv(u, w, b):
    out = lax.conv_general_dilated(
        u, w[:, None, :].astype(u.dtype), window_strides=(1,),
        padding=((SSD_CONV - 1, 0),), dimension_numbers=("NWC", "WIO", "NWC"),
        feature_group_count=u.shape[-1])
    return out + b


def ssd_mixer(z, xbc, dt_raw, conv_w, conv_b, dt_bias, a_log, d_skip, norm_w):
    b, L, _ = z.shape
    nc = L // SSD_CHUNK
    E = SSD_HEADS // SSD_GROUPS
    xbc = jax.nn.silu(causal_dwconv(xbc, conv_w, conv_b))
    xs, Bm, Cm = jnp.split(xbc, [SSD_INNER, SSD_INNER + SSD_GROUPS * SSD_STATE], axis=-1)
    dt = jax.nn.softplus(dt_raw.astype(jnp.float32) + dt_bias.astype(jnp.float32))
    A = -jnp.exp(a_log.astype(jnp.float32)).reshape(SSD_GROUPS, E)
    X = xs.reshape(b, nc, SSD_CHUNK, SSD_GROUPS, E, SSD_HEAD_DIM)
    Bc = Bm.reshape(b, nc, SSD_CHUNK, SSD_GROUPS, SSD_STATE)
    Cc = Cm.reshape(b, nc, SSD_CHUNK, SSD_GROUPS, SSD_STATE)
    dtc = dt.reshape(b, nc, SSD_CHUNK, SSD_GROUPS, E)
    Xdt = X * dtc[..., None].astype(X.dtype)
    dA = jnp.transpose(dtc * A, (0, 1, 3, 4, 2))
    A_cum = jnp.cumsum(dA, axis=-1)
    idx = jnp.arange(SSD_CHUNK)
    causal = idx[:, None] >= idx[None, :]
    Lmat = jnp.exp(jnp.where(causal, A_cum[..., :, None] - A_cum[..., None, :], -jnp.inf))
    CB = jnp.einsum("bclgn,bcsgn->bcgls", Cc, Bc)
    M = (CB[:, :, :, None] * Lmat).astype(X.dtype)
    y_diag = jnp.einsum("bcgels,bcsgep->bclgep", M, Xdt)
    decay_states = jnp.exp(A_cum[..., -1:] - A_cum).astype(X.dtype)
    states = jnp.einsum("bclgn,bcgel,bclgep->bcgepn", Bc, decay_states, Xdt)
    chunk_decay = jnp.exp(A_cum[..., -1])

    def step(h, inp):
        s_c, d_c = inp
        return h * d_c[..., None, None] + s_c, h

    h0 = jnp.zeros((b, SSD_GROUPS, E, SSD_HEAD_DIM, SSD_STATE), jnp.float32)
    _, prev = lax.scan(step, h0, (jnp.moveaxis(states, 1, 0).astype(jnp.float32),
                                  jnp.moveaxis(chunk_decay, 1, 0)))
    prev = jnp.moveaxis(prev, 0, 1).astype(X.dtype)
    y_off = jnp.einsum("bclgn,bcgepn,bcgel->bclgep", Cc, prev, jnp.exp(A_cum).astype(X.dtype))
    y = y_diag + y_off + X * d_skip.reshape(SSD_GROUPS, E)[:, :, None].astype(X.dtype)
    y = y.reshape(b, L, SSD_INNER)
    yg = (y * jax.nn.silu(z)).reshape(b, L, SSD_GROUPS, SSD_INNER // SSD_GROUPS)
    return rms_norm(yg, norm_w.reshape(SSD_GROUPS, -1)).reshape(b, L, SSD_INNER)


def moba_attention(q, k, v):
    b, L, H, Dh = q.shape
    Lp = -(-L // MOBA_BLOCK) * MOBA_BLOCK
    nb = Lp // MOBA_BLOCK
    n_sel = min(MOBA_TOPK, nb - 1)
    pad = ((0, 0), (0, Lp - L), (0, 0), (0, 0))
    qh = jnp.pad(q, pad).transpose(0, 2, 1, 3)
    k_blocks = jnp.pad(k, pad).transpose(0, 2, 1, 3).reshape(b, H, nb, MOBA_BLOCK, Dh)
    v_blocks = jnp.pad(v, pad).transpose(0, 2, 1, 3).reshape(b, H, nb, MOBA_BLOCK, Dh)
    k_mean = jnp.mean(k_blocks.astype(jnp.float32), axis=3).astype(q.dtype)
    scale = Dh ** -0.5
    bi = jnp.arange(b)[:, None, None, None]
    hi = jnp.arange(H)[None, :, None, None]
    kpos_in_blk = jnp.arange(MOBA_BLOCK)

    def chunk(c):
        q0 = c * MOBA_QCHUNK
        qc = lax.dynamic_slice_in_dim(qh, q0, MOBA_QCHUNK, axis=2)
        qpos = q0 + jnp.arange(MOBA_QCHUNK)
        own = q0 // MOBA_BLOCK
        own_idx = jnp.broadcast_to(own, (b, H, MOBA_QCHUNK, 1)).astype(jnp.int32)
        if n_sel > 0:
            gate = jnp.einsum("bhqd,bhnd->bhqn", qc, k_mean).astype(jnp.float32)
            gate = jnp.where(jnp.arange(nb) < own, gate, -jnp.inf)
            _, sel = lax.top_k(gate, n_sel)
            sel = sel.astype(jnp.int32)
            blk_idx = jnp.concatenate([sel, own_idx], axis=-1)
            slot_ok = jnp.concatenate([sel < own, jnp.ones(own_idx.shape, bool)], axis=-1)
        else:
            blk_idx = own_idx
            slot_ok = jnp.ones(own_idx.shape, bool)
        kg = k_blocks[bi, hi, blk_idx]
        vg = v_blocks[bi, hi, blk_idx]
        s = jnp.einsum("bhqd,bhqjkd->bhqjk", qc, kg).astype(jnp.float32) * scale
        kpos = blk_idx[..., None] * MOBA_BLOCK + kpos_in_blk
        mask = slot_ok[..., None] & (kpos <= qpos[:, None, None])
        s = jnp.where(mask, s, -jnp.inf)
        pr = jax.nn.softmax(s.reshape(b, H, MOBA_QCHUNK, -1), axis=-1).reshape(s.shape)
        return jnp.einsum("bhqjk,bhqjkd->bhqd", pr.astype(vg.dtype), vg)

    out = lax.map(chunk, jnp.arange(Lp // MOBA_QCHUNK))
    out = out.transpose(1, 0, 3, 2, 4).reshape(b, Lp, H, Dh)
    return out[:, :L]


def hybrid_mixer(h, positions, w_in, conv_w, conv_b, dt_bias, a_log, d_skip, ssd_norm_w,
                 w_ssd_out, w_attn_out, w_out):
    b, L, _ = h.shape
    z, xbc, dt_raw, q, k, v, g_ssd, g_att = split_columns(h @ w_in)
    y_ssd = ssd_mixer(z, xbc, dt_raw, conv_w, conv_b, dt_bias, a_log, d_skip, ssd_norm_w) @ w_ssd_out
    q = rope(q.reshape(b, L, ATT_HEADS, ATT_HEAD_DIM), positions)
    k = rope(k.reshape(b, L, ATT_HEADS, ATT_HEAD_DIM), positions)
    v = v.reshape(b, L, ATT_HEADS, ATT_HEAD_DIM)
    y_att = moba_attention(q, k, v).reshape(b, L, ATT_INNER) @ w_attn_out
    merged = jax.nn.sigmoid(g_ssd) * y_ssd + jax.nn.sigmoid(g_att) * y_att
    return merged @ w_out


def hier_moe(h, w_rg, b_rg, w_re, b_re, w_gate, w_up, w_down):
    b, L, _ = h.shape
    gl = (h @ w_rg).astype(jnp.float32) + b_rg.astype(jnp.float32)
    gp = jax.nn.softmax(gl, axis=-1)
    _, gi = lax.top_k(gl, 1)
    g_oh = jax.nn.one_hot(gi[..., 0], N_GROUPS, dtype=jnp.float32)
    g_w = jnp.sum(gp * g_oh, axis=-1)
    el = ((h @ w_re).astype(jnp.float32) + b_re.astype(jnp.float32)).reshape(b, L, N_GROUPS, EXPERTS_PER_GROUP)
    el_sel = jnp.einsum("blge,blg->ble", el, g_oh)
    top_v, top_i = lax.top_k(el_sel, TOPK_IN_GROUP)
    top_w = jax.nn.softmax(top_v, axis=-1) * g_w[..., None]
    e_w = jnp.sum(jax.nn.one_hot(top_i, EXPERTS_PER_GROUP, dtype=jnp.float32) * top_w[..., None], axis=-2)
    comb = (g_oh[..., None] * e_w[..., None, :]).astype(h.dtype)
    out = jnp.zeros_like(h)
    for g in range(N_GROUPS):
        hid = jax.nn.silu(jnp.einsum("bld,edf->blef", h, w_gate[g])) * jnp.einsum("bld,edf->blef", h, w_up[g])
        out = out + jnp.einsum("blef,ble,efd->bld", hid, comb[:, :, g], w_down[g])
    return out


def setup_inputs(seed: int = 0) -> dict:
    key = jax.random.key(seed)
    ks = jax.random.split(key, 32)
    f32 = jnp.float32

    def nrm(k, shape, fan_in):
        return jax.random.normal(k, shape, f32) * (fan_in ** -0.5)

    def gain(k, shape):
        return 1.0 + 0.05 * jax.random.normal(k, shape, f32)

    dt0 = jnp.exp(jax.random.uniform(ks[5], (DEPTH, SSD_HEADS), f32, math.log(1e-3), math.log(1e-1)))
    dt_bias = dt0 + jnp.log(-jnp.expm1(-dt0))
    return {
        "x": jax.random.normal(ks[0], (BATCH, SEQ, D_MODEL), f32),
        "p": jax.random.normal(ks[1], (DEPTH, BATCH, SEQ, PLE_DIM), f32),
        "positions": (jnp.arange(SEQ, dtype=jnp.int32)[None, :]
                      + jax.random.randint(ks[2], (BATCH, 1), 0, 1024, dtype=jnp.int32)),
        "attn_norm_w": gain(ks[3], (DEPTH, D_MODEL)),
        "w_in": nrm(ks[4], (DEPTH, D_MODEL, IN_WIDTH), D_MODEL),
        "conv_w": nrm(ks[6], (DEPTH, SSD_CONV, SSD_CONV_CH), SSD_CONV),
        "conv_b": 0.02 * jax.random.normal(ks[7], (DEPTH, SSD_CONV_CH), f32),
        "dt_bias": dt_bias,
        "a_log": jnp.log(jax.random.uniform(ks[8], (DEPTH, SSD_HEADS), f32, 1.0, 16.0)),
        "d_skip": 1.0 + 0.1 * jax.random.normal(ks[9], (DEPTH, SSD_HEADS), f32),
        "ssd_norm_w": gain(ks[10], (DEPTH, SSD_INNER)),
        "w_ssd_out": nrm(ks[11], (DEPTH, SSD_INNER, D_MODEL), SSD_INNER),
        "w_attn_out": nrm(ks[12], (DEPTH, ATT_INNER, D_MODEL), ATT_INNER),
        "w_out": nrm(ks[13], (DEPTH, D_MODEL, D_MODEL), D_MODEL),
        "moe_norm_w": gain(ks[14], (DEPTH, D_MODEL)),
        "w_router_group": nrm(ks[15], (DEPTH, D_MODEL, N_GROUPS), D_MODEL),
        "b_router_group": 0.01 * jax.random.normal(ks[16], (DEPTH, N_GROUPS), f32),
        "w_router_expert": nrm(ks[17], (DEPTH, D_MODEL, N_GROUPS * EXPERTS_PER_GROUP), D_MODEL),
        "b_router_expert": 0.01 * jax.random.normal(ks[18], (DEPTH, N_GROUPS * EXPERTS_PER_GROUP), f32),
        "w_exp_gate": nrm(ks[19], (DEPTH, N_GROUPS, EXPERTS_PER_GROUP, D_MODEL, D_EXPERT), D_MODEL),
        "w_exp_up": nrm(ks[20], (DEPTH, N_GROUPS, EXPERTS_PER_GROUP, D_MODEL, D_EXPERT), D_MODEL),
        "w_exp_down": nrm(ks[21], (DEPTH, N_GROUPS, EXPERTS_PER_GROUP, D_EXPERT, D_MODEL), D_EXPERT),
        "ple_norm_w": gain(ks[22], (DEPTH, D_MODEL)),
        "w_ple": nrm(ks[23], (DEPTH, PLE_DIM, D_MODEL), PLE_DIM),
        "w_ple_gate": nrm(ks[24], (DEPTH, D_MODEL, D_MODEL), D_MODEL),
        "final_norm_w": gain(ks[25], (D_MODEL,)),
    }


def reference(x, p, positions, attn_norm_w, w_in, conv_w, conv_b, dt_bias, a_log, d_skip,
              ssd_norm_w, w_ssd_out, w_attn_out, w_out, moe_norm_w, w_router_group,
              b_router_group, w_router_expert, b_router_expert, w_exp_gate, w_exp_up,
              w_exp_down, ple_norm_w, w_ple, w_ple_gate, final_norm_w):
    for i in range(DEPTH):
        h = rms_norm(x, attn_norm_w[i])
        x = x + hybrid_mixer(h, positions, w_in[i], conv_w[i], conv_b[i], dt_bias[i], a_log[i],
                             d_skip[i], ssd_norm_w[i], w_ssd_out[i], w_attn_out[i], w_out[i])
        h = rms_norm(x, moe_norm_w[i])
        x = x + hier_moe(h, w_router_group[i], b_router_group[i], w_router_expert[i],
                         b_router_expert[i], w_exp_gate[i], w_exp_up[i], w_exp_down[i])
        gate = jax.nn.sigmoid(rms_norm(x, ple_norm_w[i]) @ w_ple_gate[i])
        x = x + gate * (p[i] @ w_ple[i])
    return rms_norm(x, final_norm_w)
```

```cpp
#include <hip/hip_runtime.h>
#include <hip/hip_bf16.h>
#include <cstdio>
#include <cstdint>
#include <cmath>

constexpr int M_TOK = 32768;
constexpr int DMODEL = 1024;
__device__ __forceinline__ int opaque_tid() { int t = threadIdx.x; asm volatile("" : "+v"(t)); return t; }

namespace pg8 {
#define PG8_LAS __attribute__((address_space(3)))
typedef unsigned short bf16_t;
typedef short bf16x8 __attribute__((ext_vector_type(8)));
typedef float f32x4 __attribute__((ext_vector_type(4)));
typedef float f32x2 __attribute__((ext_vector_type(2)));
typedef unsigned u32x4 __attribute__((ext_vector_type(4)));
typedef unsigned u32x2 __attribute__((ext_vector_type(2)));
constexpr int BM = 256, BK = 64, HALF = 128, HTB = HALF * BK * 2  , STAGE_BYTES = 8 * HTB, NXCD = 8, WGM = 8;

__host__ __device__ __forceinline__ int lds_byte(int r, int c) { const int st = (r >> 4) * 2 + (c >> 5), rr = r & 15, cc = c & 31, ob = rr * 64 + cc * 2; return st * 1024 + (ob ^ (((ob >> 9) & 1) << 5)); }
__host__ __device__ __forceinline__ void stage_rc(int b, int& R, int& C) { const int st = b / 1024, sb = b % 1024, swz = sb ^ (((sb >> 9) & 1) << 5); R = (st >> 1) * 16 + swz / 64; C = (st & 1) * 32 + (swz % 64) / 2; }
__host__ __device__ __forceinline__ int perm32(int rho) { const int n = rho >> 4, i = rho & 15; return 8 * (i >> 2) + 4 * n + (i & 3); }

struct Unit { int pm, pn, am, bn, aux; };
struct Gemm { const bf16_t* A; const bf16_t* Bt; int M, N, K; };

struct StaticOrder {
    int nM, nN, nwg, G, c;
    __host__ __device__ void init(int M, int N, int G_, int c_) { nM = M / BM; nN = N / BM; nwg = nM * nN; G = G_; c = c_; }
    __host__ __device__ bool map(long L, int& pm, int& pn) const {
        if (L >= nwg) return false;
        int wgid = (int)L; { const int q = nwg / NXCD, r = nwg % NXCD, xcd = wgid % NXCD, off = wgid / NXCD; wgid = (xcd < r ? xcd * (q + 1) : r * (q + 1) + (xcd - r) * q) + off; }
        const int nig = WGM * nN, gid = wgid / nig, fm = gid * WGM, gsz = (nM - fm) < WGM ? (nM - fm) : WGM;
        pm = fm + ((wgid % nig) % gsz); pn = (wgid % nig) / gsz; return true;
    }
    __host__ __device__ bool next(int i, Unit& u) const {
        if (!map((long)i * G + c, u.pm, u.pn)) return false;
        u.am = u.pm; u.bn = u.pn; u.aux = 0; return true;
    }
    __device__ __forceinline__ void a_ready(const Unit&) const {}
    __device__ __forceinline__ void done(const Unit&) const {}
};
struct DualOrder : StaticOrder {
    int a_off, b_off;
    __host__ __device__ bool next(int i, Unit& u) const {
        if (!map((long)(i >> 1) * G + c, u.pm, u.pn)) return false;
        u.aux = i & 1; u.am = u.pm + (u.aux ? a_off : 0); u.bn = u.pn + (u.aux ? b_off : 0); return true;
    }
};
template <int NSUB> struct MoeOrder {
    const int* tile_e; int ntiles, G, c;
    __device__ bool next(int i, Unit& u) const {
        const long L = (long)i * G + c; if (L >= (long)ntiles * NSUB) return false;
        const int t = (int)(L / NSUB), sub = (int)(L % NSUB); const int e = __builtin_amdgcn_readfirstlane(tile_e[t]);
        u.pm = t; u.pn = sub; u.am = t; u.bn = e * NSUB + sub; u.aux = 0; return true;
    }
    __device__ __forceinline__ void a_ready(const Unit&) const {}
    __device__ __forceinline__ void done(const Unit&) const {}
};

typedef __bf16 bf16x2_t __attribute__((ext_vector_type(2)));
__device__ __forceinline__ unsigned cvt_pk_bf16(float lo, float hi) { f32x2 v = {lo, hi}; bf16x2_t b = __builtin_convertvector(v, bf16x2_t); return __builtin_bit_cast(unsigned, b); }
__device__ __forceinline__ float bf_lo(unsigned w) { return __builtin_bit_cast(float, w << 16); }
__device__ __forceinline__ float bf_hi(unsigned w) { return __builtin_bit_cast(float, w & 0xffff0000u); }
__device__ __forceinline__ float sigmoidf_(float x) { return __builtin_amdgcn_rcpf(1.0f + __expf(-x)); }
__device__ __forceinline__ float siluf_(float x) { return x * sigmoidf_(x); }
__device__ __forceinline__ u32x4 pack8(const f32x4& v0, const f32x4& v1) { u32x4 w; w.x = cvt_pk_bf16(v0[0], v0[1]); w.y = cvt_pk_bf16(v0[2], v0[3]); w.z = cvt_pk_bf16(v1[0], v1[1]); w.w = cvt_pk_bf16(v1[2], v1[3]); return w; }

struct EpiPlain {
    static constexpr bool PERM = true, AFTER_DRAIN = false;
    bf16_t* O; int ldc;
    __device__ __forceinline__ void operator()(const f32x4 (&acc)[2][2][4][2], const Unit& u, int wr, int wc, int fr, int fq) const {
        const int row0 = u.pm * BM + wr * 64 + fr, col0 = u.pn * BM + wc * 32 + 8 * fq;
#pragma unroll
        for (int ai = 0; ai < 2; ++ai)
#pragma unroll
            for (int m = 0; m < 4; ++m) { bf16_t* rowp = O + (size_t)(row0 + ai * HALF + m * 16) * ldc + col0;
#pragma unroll
                for (int bj = 0; bj < 2; ++bj) *(u32x4*)(rowp + bj * HALF) = pack8(acc[ai][bj][m][0], acc[ai][bj][m][1]); }
    }
};
struct EpiInProj {
    static constexpr bool PERM = true, AFTER_DRAIN = false;
    bf16_t* buf0; bf16_t* buf1; bf16_t* bc; float* dt; const float* rope; const float* dt_bias; float qscale;
    __device__ __forceinline__ void operator()(const f32x4 (&acc)[2][2][4][2], const Unit& u, int wr, int wc, int fr, int fq) const {
        const int row0 = u.pm * BM + wr * 64 + fr; const int pn = u.pn;
        if (pn < 28) {
            const int t = pn >> 2; const int col0 = (pn & 3) * BM + wc * 32 + 8 * fq;
            bf16_t* base = (t < 5) ? buf0 + (size_t)t * M_TOK * 1024 : buf1 + (size_t)(t - 5) * M_TOK * 1024;
            if (t == 2 || t == 3) {
                const float sc = (t == 2) ? qscale : 1.0f; const int i0 = 16 * (wc & 1) + 4 * fq;
#pragma unroll
                for (int ai = 0; ai < 2; ++ai)
#pragma unroll
                    for (int m = 0; m < 4; ++m) { const int row = row0 + ai * HALF + m * 16; bf16_t* rowp = base + (size_t)row * 1024 + col0;
                        const f32x4 cs0 = *(const f32x4*)(rope + (size_t)row * 64 + 2 * i0), cs1 = *(const f32x4*)(rope + (size_t)row * 64 + 2 * i0 + 4);
#pragma unroll
                        for (int bj = 0; bj < 2; ++bj) { const f32x4 a = acc[ai][bj][m][0], b = acc[ai][bj][m][1]; f32x4 v0, v1;
                            v0[0] = (a[0] * cs0[0] - a[1] * cs0[1]) * sc; v0[1] = (a[1] * cs0[0] + a[0] * cs0[1]) * sc;
                            v0[2] = (a[2] * cs0[2] - a[3] * cs0[3]) * sc; v0[3] = (a[3] * cs0[2] + a[2] * cs0[3]) * sc;
                            v1[0] = (b[0] * cs1[0] - b[1] * cs1[1]) * sc; v1[1] = (b[1] * cs1[0] + b[0] * cs1[1]) * sc;
                            v1[2] = (b[2] * cs1[2] - b[3] * cs1[3]) * sc; v1[3] = (b[3] * cs1[2] + b[2] * cs1[3]) * sc;
                            *(u32x4*)(rowp + bj * HALF) = pack8(v0, v1); } }
            } else if (t >= 5) {
#pragma unroll
                for (int ai = 0; ai < 2; ++ai)
#pragma unroll
                    for (int m = 0; m < 4; ++m) { bf16_t* rowp = base + (size_t)(row0 + ai * HALF + m * 16) * 1024 + col0;
#pragma unroll
                        for (int bj = 0; bj < 2; ++bj) { f32x4 v0 = acc[ai][bj][m][0], v1 = acc[ai][bj][m][1];
#pragma unroll
                            for (int j = 0; j < 4; ++j) { v0[j] = sigmoidf_(v0[j]); v1[j] = sigmoidf_(v1[j]); }
                            *(u32x4*)(rowp + bj * HALF) = pack8(v0, v1); } }
            } else {
#pragma unroll
                for (int ai = 0; ai < 2; ++ai)
#pragma unroll
                    for (int m = 0; m < 4; ++m) { bf16_t* rowp = base + (size_t)(row0 + ai * HALF + m * 16) * 1024 + col0;
#pragma unroll
                        for (int bj = 0; bj < 2; ++bj) *(u32x4*)(rowp + bj * HALF) = pack8(acc[ai][bj][m][0], acc[ai][bj][m][1]); }
            }
        } else if (pn == 28) {
            const int col0 = wc * 32 + 8 * fq;
#pragma unroll
            for (int ai = 0; ai < 2; ++ai)
#pragma unroll
                for (int m = 0; m < 4; ++m) { bf16_t* rowp = bc + (size_t)(row0 + ai * HALF + m * 16) * 256 + col0;
#pragma unroll
                    for (int bj = 0; bj < 2; ++bj) *(u32x4*)(rowp + bj * HALF) = pack8(acc[ai][bj][m][0], acc[ai][bj][m][1]); }
        } else {
            if (wc == 0 && fq < 2) {
                const int c0 = 8 * fq;
#pragma unroll
                for (int ai = 0; ai < 2; ++ai)
#pragma unroll
                    for (int m = 0; m < 4; ++m) { float* rowp = dt + (size_t)(row0 + ai * HALF + m * 16) * 16 + c0;
#pragma unroll
                        for (int n = 0; n < 2; ++n) { f32x4 v = acc[ai][0][m][n];
#pragma unroll
                            for (int j = 0; j < 4; ++j) { const float x = v[j] + dt_bias[c0 + 4 * n + j]; v[j] = x > 20.f ? x : log1pf(__expf(x)); }
                            *(f32x4*)(rowp + 4 * n) = v; } }
            }
        }
    }
};
struct EpiMerge {
    static constexpr bool PERM = true, AFTER_DRAIN = false;
    bf16_t* MG; const bf16_t* G0; const bf16_t* G1;
    __device__ __forceinline__ void operator()(const f32x4 (&acc)[2][2][4][2], const Unit& u, int wr, int wc, int fr, int fq) const {
        const int row0 = u.pm * BM + wr * 64 + fr, col0 = u.pn * BM + wc * 32 + 8 * fq; const bf16_t* G = u.aux ? G1 : G0;
#pragma unroll
        for (int ai = 0; ai < 2; ++ai)
#pragma unroll
            for (int m = 0; m < 4; ++m) { const size_t off = (size_t)(row0 + ai * HALF + m * 16) * 1024 + col0;
#pragma unroll
                for (int bj = 0; bj < 2; ++bj) { const u32x4 g = *(const u32x4*)(G + off + bj * HALF); f32x4 v0 = acc[ai][bj][m][0], v1 = acc[ai][bj][m][1];
                    v0[0] *= bf_lo(g.x); v0[1] *= bf_hi(g.x); v0[2] *= bf_lo(g.y); v0[3] *= bf_hi(g.y); v1[0] *= bf_lo(g.z); v1[1] *= bf_hi(g.z); v1[2] *= bf_lo(g.w); v1[3] *= bf_hi(g.w);
                    if (u.aux) { const u32x4 p = *(const u32x4*)(MG + off + bj * HALF);
                        v0[0] += bf_lo(p.x); v0[1] += bf_hi(p.x); v0[2] += bf_lo(p.y); v0[3] += bf_hi(p.y); v1[0] += bf_lo(p.z); v1[1] += bf_hi(p.z); v1[2] += bf_lo(p.w); v1[3] += bf_hi(p.w); }
                    *(u32x4*)(MG + off + bj * HALF) = pack8(v0, v1); } }
    }
};
struct EpiResid {
    static constexpr bool PERM = false, AFTER_DRAIN = false;
    float* C; const float* R;
    __device__ __forceinline__ void operator()(const f32x4 (&acc)[2][2][4][2], const Unit& u, int wr, int wc, int fr, int fq) const {
        const int row0 = u.pm * BM + wr * 64 + fr, col0 = u.pn * BM + wc * 32 + 4 * fq;
#pragma unroll
        for (int ai = 0; ai < 2; ++ai)
#pragma unroll
            for (int m = 0; m < 4; ++m) { const size_t off = (size_t)(row0 + ai * HALF + m * 16) * 1024 + col0;
#pragma unroll
                for (int bj = 0; bj < 2; ++bj)
#pragma unroll
                    for (int n = 0; n < 2; ++n) { const f32x4 r = *(const f32x4*)(R + off + bj * HALF + n * 16); *(f32x4*)(C + off + bj * HALF + n * 16) = acc[ai][bj][m][n] + r; } }
    }
};
struct EpiHid {
    static constexpr bool PERM = true, AFTER_DRAIN = false;
    bf16_t* HID;
    __device__ __forceinline__ void operator()(const f32x4 (&acc)[2][2][4][2], const Unit& u, int wr, int wc, int fr, int fq) const {
        const int row0 = u.pm * BM + wr * 64 + fr, col0 = u.pn * HALF + wc * 32 + 8 * fq;
#pragma unroll
        for (int ai = 0; ai < 2; ++ai)
#pragma unroll
            for (int m = 0; m < 4; ++m) { f32x4 v0, v1;
#pragma unroll
                for (int j = 0; j < 4; ++j) { v0[j] = siluf_(acc[ai][0][m][0][j]) * acc[ai][1][m][0][j]; v1[j] = siluf_(acc[ai][0][m][1][j]) * acc[ai][1][m][1][j]; }
                *(u32x4*)(HID + (size_t)(row0 + ai * HALF + m * 16) * 256 + col0) = pack8(v0, v1); }
    }
};
struct EpiPle {
    static constexpr bool PERM = false, AFTER_DRAIN = false;
    float* X; const bf16_t* PE;
    __device__ __forceinline__ void operator()(const f32x4 (&acc)[2][2][4][2], const Unit& u, int wr, int wc, int fr, int fq) const {
        const int row0 = u.pm * BM + wr * 64 + fr, col0 = u.pn * BM + wc * 32 + 4 * fq;
#pragma unroll
        for (int ai = 0; ai < 2; ++ai)
#pragma unroll
            for (int m = 0; m < 4; ++m) { const size_t off = (size_t)(row0 + ai * HALF + m * 16) * 1024 + col0;
#pragma unroll
                for (int bj = 0; bj < 2; ++bj)
#pragma unroll
                    for (int n = 0; n < 2; ++n) { const size_t o2 = off + bj * HALF + n * 16; const f32x4 x = *(const f32x4*)(X + o2); const u32x2 p = *(const u32x2*)(PE + o2); const f32x4 a = acc[ai][bj][m][n]; f32x4 r;
                        r[0] = x[0] + sigmoidf_(a[0]) * bf_lo(p.x); r[1] = x[1] + sigmoidf_(a[1]) * bf_hi(p.x); r[2] = x[2] + sigmoidf_(a[2]) * bf_lo(p.y); r[3] = x[3] + sigmoidf_(a[3]) * bf_hi(p.y);
                        *(f32x4*)(X + o2) = r; } }
    }
};


template <class Epi, class Sched, bool ALIGN_EPI = false, bool SP2 = false>
__device__ __forceinline__ void gemm_phase(PG8_LAS unsigned char* lds, const Gemm g, const Sched& S, const Epi& E) {
    const int tid = opaque_tid(), wid = __builtin_amdgcn_readfirstlane(tid >> 6), lane = tid & 63, wr = wid >> 2, wc = wid & 3, fr = lane & 15, fq = lane >> 4;
    int K_ = g.K; asm volatile("" : "+s"(K_)); const int K = K_, nt = K / BK;
    unsigned voffA[2], voffB[2];
#pragma unroll
    for (int i = 0; i < 2; ++i) { int R, C; stage_rc(tid * 16 + i * 8192, R, C); const int Rb = Epi::PERM ? ((R & ~31) + perm32(R & 31)) : R;
        voffA[i] = (unsigned)(R * K + C) * 2u; voffB[i] = (unsigned)(Rb * K + C) * 2u; }
    const size_t kstep = (size_t)(BK * 2);
    const size_t hstep = (size_t)HALF * K * 2;
    const size_t tstep = 2 * hstep;
    const unsigned ldsw = (unsigned)wid * 1024u;
    const int aoff = lds_byte(wr * 64 + fr, fq * 8), boff = lds_byte(wc * 32 + fr, fq * 8);
#define PG8_SA(b, h) (((b) * 2 + (h)) * HTB)
#define PG8_SB(b, h) ((4 + (b) * 2 + (h)) * HTB)
#define PG8_STAGE(bufoff, gbase, voff) do { _Pragma("unroll") for (int _i = 0; _i < 2; ++_i) \
        __builtin_amdgcn_global_load_lds((const unsigned*)((const char*)(gbase) + (voff)[_i]), (PG8_LAS unsigned*)(lds + (bufoff) + ldsw + _i * 8192), 16, 0, 0); } while (0)
#define PG8_LDA(dst, b, h) do { _Pragma("unroll") for (int m = 0; m < 4; ++m) _Pragma("unroll") for (int k = 0; k < 2; ++k) dst[m][k] = *(const PG8_LAS bf16x8*)(lds + PG8_SA(b, h) + aoff + m * 2048 + k * 1024); } while (0)
#define PG8_LDB(dst, b, h) do { _Pragma("unroll") for (int n = 0; n < 2; ++n) _Pragma("unroll") for (int k = 0; k < 2; ++k) dst[n][k] = *(const PG8_LAS bf16x8*)(lds + PG8_SB(b, h) + boff + n * 2048 + k * 1024); } while (0)
#define PG8_MMA(ai, bj, At, Bt) do { __builtin_amdgcn_s_setprio(1); _Pragma("unroll") for (int m = 0; m < 4; ++m) _Pragma("unroll") for (int n = 0; n < 2; ++n) _Pragma("unroll") for (int k = 0; k < 2; ++k) \
        acc[ai][bj][m][n] = __builtin_amdgcn_mfma_f32_16x16x32_bf16(Bt[n][k], At[m][k], acc[ai][bj][m][n], 0, 0, 0); __builtin_amdgcn_s_setprio(0); } while (0)
#define PG8_WAIT_V(n) asm volatile("s_waitcnt vmcnt(" #n ")" ::: "memory")
#define PG8_WAIT_L(n) asm volatile("s_waitcnt lgkmcnt(" #n ")" ::: "memory")
#define PG8_BAR __builtin_amdgcn_s_barrier()
#define PG8_SCHED __builtin_amdgcn_sched_barrier(0)
    Unit cur, nxt; int ui = 0;
    if (!S.next(0, cur)) return;
    f32x4 acc[2][2][4][2];
#pragma unroll
    for (int a = 0; a < 2; ++a)
#pragma unroll
        for (int b = 0; b < 2; ++b)
#pragma unroll
            for (int m = 0; m < 4; ++m)
#pragma unroll
                for (int n = 0; n < 2; ++n) acc[a][b][m][n] = (f32x4){0.f, 0.f, 0.f, 0.f};
    bf16x8 At[4][2], B0[2][2], B1[2][2];
    const char* cA = (const char*)g.A + (size_t)cur.am * tstep; const char* cB = (const char*)g.Bt + (size_t)cur.bn * tstep;
    S.a_ready(cur);
    if constexpr (SP2) {
        PG8_STAGE(PG8_SB(0, 0), cB, voffB); PG8_STAGE(PG8_SB(0, 1), cB + hstep, voffB); PG8_STAGE(PG8_SA(0, 0), cA, voffA); PG8_STAGE(PG8_SA(0, 1), cA + hstep, voffA);
        if (wr == 1) PG8_BAR;
        PG8_WAIT_V(2); PG8_BAR;
        PG8_STAGE(PG8_SB(1, 0), cB + kstep, voffB); PG8_STAGE(PG8_SA(1, 0), cA + kstep, voffA); PG8_STAGE(PG8_SB(1, 1), cB + hstep + kstep, voffB);
        PG8_WAIT_V(6); PG8_BAR;
    } else {
        PG8_STAGE(PG8_SB(0, 0), cB, voffB); PG8_STAGE(PG8_SA(0, 0), cA, voffA); PG8_STAGE(PG8_SB(0, 1), cB + hstep, voffB); PG8_STAGE(PG8_SA(0, 1), cA + hstep, voffA);
        if (wr == 1) PG8_BAR;
        PG8_WAIT_V(4); PG8_BAR;
        PG8_STAGE(PG8_SB(1, 0), cB + kstep, voffB); PG8_STAGE(PG8_SA(1, 0), cA + kstep, voffA); PG8_STAGE(PG8_SB(1, 1), cB + hstep + kstep, voffB);
        PG8_WAIT_V(6); PG8_BAR;
    }
    for (;;) {
        const bool has_next = S.next(ui + 1, nxt);
        const char* nA = has_next ? (const char*)g.A + (size_t)nxt.am * tstep : cA; const char* nB = has_next ? (const char*)g.Bt + (size_t)nxt.bn * tstep : cB;
        for (int t = 0; t < nt; t += 2) {
            const bool last = (t == nt - 2);
            const char* a1 = cA + (size_t)(t + 1) * kstep;
            const char* a2 = last ? nA : cA + (size_t)(t + 2) * kstep; const char* b2 = last ? nB : cB + (size_t)(t + 2) * kstep;
            const char* a3 = a2 + kstep; const char* b3 = b2 + kstep;
            if (last && has_next) S.a_ready(nxt);
            if constexpr (SP2) {
            PG8_LDB(B0, 0, 0); PG8_LDB(B1, 0, 1); PG8_SCHED; PG8_LDA(At, 0, 0); PG8_STAGE(PG8_SA(1, 1), a1 + hstep, voffA);
            PG8_WAIT_V(8); PG8_WAIT_L(0); PG8_BAR; PG8_MMA(0, 0, At, B0); PG8_MMA(0, 1, At, B1); PG8_BAR; PG8_SCHED;
            PG8_LDA(At, 0, 1); PG8_STAGE(PG8_SB(0, 0), b2, voffB); PG8_STAGE(PG8_SB(0, 1), b2 + hstep, voffB); PG8_STAGE(PG8_SA(0, 0), a2, voffA);
            PG8_WAIT_V(8); PG8_WAIT_L(0); PG8_BAR; PG8_MMA(1, 0, At, B0); PG8_MMA(1, 1, At, B1); PG8_BAR; PG8_SCHED;
            PG8_LDB(B0, 1, 0); PG8_LDB(B1, 1, 1); PG8_SCHED; PG8_LDA(At, 1, 0); PG8_STAGE(PG8_SA(0, 1), a2 + hstep, voffA);
            PG8_WAIT_V(8); PG8_WAIT_L(0); PG8_BAR; PG8_MMA(0, 0, At, B0); PG8_MMA(0, 1, At, B1); PG8_BAR; PG8_SCHED;
            PG8_LDA(At, 1, 1); PG8_STAGE(PG8_SB(1, 0), b3, voffB); PG8_STAGE(PG8_SB(1, 1), b3 + hstep, voffB); PG8_STAGE(PG8_SA(1, 0), a3, voffA);
            PG8_WAIT_V(8); PG8_WAIT_L(0); PG8_BAR; PG8_MMA(1, 0, At, B0); PG8_MMA(1, 1, At, B1); PG8_BAR; PG8_SCHED;
            } else {
            PG8_LDB(B0, 0, 0); PG8_SCHED; PG8_LDA(At, 0, 0); PG8_STAGE(PG8_SA(1, 1), a1 + hstep, voffA);
            PG8_WAIT_L(8); PG8_BAR; PG8_WAIT_L(0); PG8_MMA(0, 0, At, B0); PG8_BAR; PG8_SCHED;
            PG8_LDB(B1, 0, 1); PG8_STAGE(PG8_SB(0, 0), b2, voffB);
            PG8_BAR; PG8_WAIT_L(0); PG8_MMA(0, 1, At, B1); PG8_BAR;
            PG8_LDA(At, 0, 1); PG8_STAGE(PG8_SA(0, 0), a2, voffA);
            PG8_BAR; PG8_WAIT_L(0); PG8_MMA(1, 0, At, B0); PG8_BAR; PG8_SCHED;
            PG8_STAGE(PG8_SB(0, 1), b2 + hstep, voffB);
            PG8_WAIT_V(6); PG8_BAR; PG8_MMA(1, 1, At, B1); PG8_BAR;
            PG8_LDB(B0, 1, 0); PG8_SCHED; PG8_LDA(At, 1, 0); PG8_STAGE(PG8_SA(0, 1), a2 + hstep, voffA);
            PG8_WAIT_L(8); PG8_BAR; PG8_WAIT_L(0); PG8_MMA(0, 0, At, B0); PG8_BAR; PG8_SCHED;
            PG8_LDB(B1, 1, 1); PG8_STAGE(PG8_SB(1, 0), b3, voffB);
            PG8_BAR; PG8_WAIT_L(0); PG8_MMA(0, 1, At, B1); PG8_BAR;
            PG8_LDA(At, 1, 1); PG8_STAGE(PG8_SA(1, 0), a3, voffA);
            PG8_BAR; PG8_WAIT_L(0); PG8_MMA(1, 0, At, B0); PG8_BAR; PG8_SCHED;
            PG8_STAGE(PG8_SB(1, 1), b3 + hstep, voffB);
            PG8_WAIT_V(6); PG8_BAR; PG8_MMA(1, 1, At, B1); PG8_BAR;
            }
        }
        if constexpr (ALIGN_EPI) { if (wr == 0) PG8_BAR; }
        if constexpr (!Epi::AFTER_DRAIN) { E(acc, cur, wr, wc, fr, fq); S.done(cur); }
        if (!has_next) break;
#pragma unroll
        for (int a = 0; a < 2; ++a)
#pragma unroll
            for (int b = 0; b < 2; ++b)
#pragma unroll
                for (int m = 0; m < 4; ++m)
#pragma unroll
                    for (int n = 0; n < 2; ++n) acc[a][b][m][n] = (f32x4){0.f, 0.f, 0.f, 0.f};
        cur = nxt; cA = nA; cB = nB; ++ui;
        if constexpr (ALIGN_EPI) { if (wr == 1) PG8_BAR; }
    }
    PG8_WAIT_V(0);
    if constexpr (!ALIGN_EPI) { if (wr == 0) PG8_BAR; }
    PG8_BAR;
    if constexpr (Epi::AFTER_DRAIN) { E.fused(acc, cur, wr, wc, fr, fq, lds, wid, lane); S.done(cur); }
#undef PG8_SA
#undef PG8_SB
#undef PG8_STAGE
#undef PG8_LDA
#undef PG8_LDB
#undef PG8_MMA
#undef PG8_WAIT_V
#undef PG8_WAIT_L
#undef PG8_BAR
#undef PG8_SCHED
}
}

namespace attn_body {
using bf16=__hip_bfloat16;
using bf16x8=__attribute__((ext_vector_type(8)))short;
using s16x4=__attribute__((ext_vector_type(4)))short;
using f32x16=__attribute__((ext_vector_type(16)))float;
using u32x4=__attribute__((ext_vector_type(4)))unsigned;
constexpr int BATCH=8,NHEAD=16,SEQ=4096,D=64,DM=NHEAD*D;
constexpr int NW=8,QBLK=32,QB=QBLK*NW,KVBLK=64,NQB=SEQ/QB;
constexpr int ATTN_PITCH=DM, ATTN_UNIT_ROWS=QB;
__device__ __forceinline__ int crow(int r,int hi){return (r&3)+8*(r>>2)+4*hi;}
#define SBAR() __builtin_amdgcn_sched_barrier(0)
__device__ __forceinline__ void cmask(f32x16&p0,f32x16&p1,int jb,int qrel,int hi){
  const float NEG=-INFINITY; int kb=64*jb+4*hi;
  #pragma unroll
  for(int r=0;r<16;++r){int kv=kb+(r&3)+8*(r>>2); if(kv>qrel)p0[r]=NEG; if(kv+32>qrel)p1[r]=NEG;}
}

constexpr int NSLOT=3, SLOTB=8192;
constexpr int LDS_K=0, LDS_V=NSLOT*SLOTB, LDS_WS=2*NSLOT*SLOTB, LDS_OST=LDS_WS+NW*64*4, LDS_BYTES=LDS_OST+NW*4096;
constexpr float C2=0.125f*1.4426950408889634f;
__device__ __forceinline__ void glds16(const void*gsrc,unsigned lds_dst){unsigned keep;
  asm volatile("s_mov_b32 %0, m0\n\ts_mov_b32 m0, %2\n\ts_nop 0\n\tglobal_load_lds_dwordx4 %1, off\n\ts_mov_b32 m0, %0":"=&s"(keep):"v"(gsrc),"s"(lds_dst):"memory");}
__device__ __forceinline__ float max3f(float a,float b,float c){float r;asm("v_max3_f32 %0, %1, %2, %3":"=v"(r):"v"(a),"v"(b),"v"(c));return r;}
__device__ __forceinline__ float max2f(float a,float b){float r;asm("v_max_f32_e32 %0, %1, %2":"=v"(r):"v"(a),"v"(b));return r;}
__device__ __forceinline__ float fadd_s(float a,float b){float r;asm("v_add_f32_e32 %0, %1, %2":"=v"(r):"v"(a),"v"(b));return r;}
__device__ __forceinline__ float fsub_s(float a,float b){float r;asm("v_sub_f32_e32 %0, %1, %2":"=v"(r):"v"(a),"v"(b));return r;}
typedef float f32x2_t __attribute__((ext_vector_type(2))); typedef __bf16 bf16x2_t __attribute__((ext_vector_type(2)));
__device__ __forceinline__ unsigned cvtpk_s(float lo,float hi){f32x2_t v={lo,hi};bf16x2_t b=__builtin_convertvector(v,bf16x2_t);return __builtin_bit_cast(unsigned,b);}
#define WAIT_BAR(N) asm volatile("s_waitcnt vmcnt(" #N ") lgkmcnt(0)\n\ts_barrier":::"memory")

__device__ __forceinline__ void qkt(f32x16&p0,f32x16&p1,const char*Kslot,const bf16x8*qr,int r32,int hi){ const f32x16 negm=f32x16{};
  const char*kb=Kslot+hi*1024+r32*16;
  #pragma unroll
  for(int d0=0;d0<4;++d0){
    const bf16x8 b0=*reinterpret_cast<const bf16x8*>(kb+d0*2048);
    const bf16x8 b1=*reinterpret_cast<const bf16x8*>(kb+d0*2048+512);
    if(d0==0){p0=__builtin_amdgcn_mfma_f32_32x32x16_bf16(b0,qr[0],negm,0,0,0);p1=__builtin_amdgcn_mfma_f32_32x32x16_bf16(b1,qr[0],negm,0,0,0);}
    else{p0=__builtin_amdgcn_mfma_f32_32x32x16_bf16(b0,qr[d0],p0,0,0,0);p1=__builtin_amdgcn_mfma_f32_32x32x16_bf16(b1,qr[d0],p1,0,0,0);}}
}
typedef __attribute__((address_space(3))) const char* lds_cptr;
typedef short v4i16_t __attribute__((ext_vector_type(4)));
__device__ __forceinline__ void kload8(bf16x8*kf,lds_cptr kp){
  kf[0]=*(const __attribute__((address_space(3))) bf16x8*)(kp);      kf[1]=*(const __attribute__((address_space(3))) bf16x8*)(kp+512);
  kf[2]=*(const __attribute__((address_space(3))) bf16x8*)(kp+2048); kf[3]=*(const __attribute__((address_space(3))) bf16x8*)(kp+2560);
  kf[4]=*(const __attribute__((address_space(3))) bf16x8*)(kp+4096); kf[5]=*(const __attribute__((address_space(3))) bf16x8*)(kp+4608);
  kf[6]=*(const __attribute__((address_space(3))) bf16x8*)(kp+6144); kf[7]=*(const __attribute__((address_space(3))) bf16x8*)(kp+6656);
}
__device__ __forceinline__ void kload2(bf16x8*kf,lds_cptr kp,int j){ kf[2*j]=*(const __attribute__((address_space(3))) bf16x8*)(kp+j*2048); kf[2*j+1]=*(const __attribute__((address_space(3))) bf16x8*)(kp+j*2048+512); }
__device__ __forceinline__ s16x4 vtr(lds_cptr p){ return __builtin_bit_cast(s16x4,__builtin_amdgcn_ds_read_tr16_b64_v4i16((__attribute__((address_space(3))) v4i16_t*)p)); }
__device__ __forceinline__ float rowmax(const f32x16&p0,const f32x16&p1){
  float a=max3f(p0[0],p0[1],p1[0]),b=max3f(p0[2],p0[3],p1[1]);a=max3f(a,p1[2],p1[3]);
  #pragma unroll
  for(int r=4;r<16;r+=4){a=max3f(a,p0[r],p0[r+1]);b=max3f(b,p0[r+2],p0[r+3]);a=max3f(a,p1[r],p1[r+1]);b=max3f(b,p1[r+2],p1[r+3]);}
  const float m=max2f(a,b);
  auto rr=__builtin_amdgcn_permlane32_swap(__float_as_uint(m),__float_as_uint(m),false,false);
  return max2f(__uint_as_float(rr[0]),__uint_as_float(rr[1]));
}
__device__ __forceinline__ void pv(f32x16*o,int vb,bf16x8 pa0,bf16x8 pa1,bf16x8 pa2,bf16x8 pa3){
  #pragma unroll
  for(int d0=0;d0<2;++d0){s16x4 lo[4],hi[4];
    #pragma unroll
    for(int ks=0;ks<4;++ks){
      asm volatile("ds_read_b64_tr_b16 %0,%1 offset:%c2":"=&v"(lo[ks]):"v"(vb),"i"(d0*4096+ks*1024):"memory");
      asm volatile("ds_read_b64_tr_b16 %0,%1 offset:%c2":"=&v"(hi[ks]):"v"(vb),"i"(d0*4096+ks*1024+512):"memory");}
    asm volatile("s_waitcnt lgkmcnt(0)":::"memory");SBAR();
    #define PK(k) (bf16x8){lo[k][0],lo[k][1],lo[k][2],lo[k][3],hi[k][0],hi[k][1],hi[k][2],hi[k][3]}
    o[d0]=__builtin_amdgcn_mfma_f32_32x32x16_bf16(pa0,PK(0),o[d0],0,0,0);
    o[d0]=__builtin_amdgcn_mfma_f32_32x32x16_bf16(pa1,PK(1),o[d0],0,0,0);
    o[d0]=__builtin_amdgcn_mfma_f32_32x32x16_bf16(pa2,PK(2),o[d0],0,0,0);
    o[d0]=__builtin_amdgcn_mfma_f32_32x32x16_bf16(pa3,PK(3),o[d0],0,0,0);
    #undef PK
  }
}

#ifndef ATTN_STORE16
#define ATTN_STORE16(p,v) (*(u32x4*)(p)=(v))
#endif
template<int THRL> __device__ __forceinline__ void attn_unit(int b,int h,int qb,const bf16*Q,const bf16*__restrict__ K,const bf16*__restrict__ V,bf16*O,const bf16*__restrict__ KM,char*shm){
  const int tid=opaque_tid(),lane=tid&63,r32=lane&31,hi=lane>>5; const int wid=__builtin_amdgcn_readfirstlane(tid>>6);
  const long rowbase=(long)b*SEQ; const int q0=qb*QB;
  const bf16*Qw=Q+(rowbase+q0+wid*QBLK)*DM+h*D;
  const bf16*Kh=K+rowbase*DM+h*D,*Vh=V+rowbase*DM+h*D;
  const unsigned lds0=(unsigned)(uintptr_t)shm;
  float*wsf=(float*)(shm+LDS_WS)+wid*64;
  const bf16*ksrc=Kh+(long)lane*DM+wid*8;
  const bf16*vsrc=Vh+(long)(16*(wid&3)+(lane>>2))*DM+(wid>>2)*32+(lane&3)*8;
  const unsigned kdst=lds0+LDS_K+wid*1024, vdst=lds0+LDS_V+wid*1024;
  #define PHYS(t) (((t)<4)?(NT-4+(t)):((t)-4))
  #define DMA_K(t,slot) glds16(ksrc+(long)PHYS(t)*KVBLK*DM,(unsigned)__builtin_amdgcn_readfirstlane(kdst+(slot)))
  #define DMA_V(t,slot) glds16(vsrc+(long)PHYS(t)*KVBLK*DM,(unsigned)__builtin_amdgcn_readfirstlane(vdst+(slot)))
  const int vb0=(int)(lds0+LDS_V)+((lane>>4)&1)*32+(lane&3)*8+(4*hi+((lane&15)>>2))*64;
  const char*Kbase=shm+LDS_K; bf16x8 kf[8];
  const lds_cptr shm3=(lds_cptr)shm; const lds_cptr kp0=shm3+LDS_K+hi*1024+r32*16; const lds_cptr vp0=shm3+LDS_V+((lane>>4)&1)*32+(lane&3)*8+(4*hi+((lane&15)>>2))*64;
  const int NT=(q0+QB)/KVBLK;
  DMA_K(0,0);DMA_V(0,0);DMA_K(1,SLOTB);
  bf16x8 qr[4];
  #pragma unroll
  for(int d0=0;d0<4;++d0)qr[d0]=*reinterpret_cast<const bf16x8*>(&Qw[(long)r32*DM+d0*16+hi*8]);
  float mhat=0.f,l_reg=0.f;f32x16 o[2];o[0]=f32x16{};o[1]=f32x16{};
  const int qrel=wid*QBLK+r32; const f32x16 zero16=f32x16{};
  unsigned selmask=0u;
  if(qb>0){ f32x16 g0=f32x16{};
    const bf16*kmp=KM+((long)(b*NHEAD+h)*16+(r32&15))*D+hi*8;
    _Pragma("unroll") for(int d0=0;d0<4;++d0){ bf16x8 kk=*reinterpret_cast<const bf16x8*>(kmp+d0*16); if(r32>=16)kk=bf16x8{}; g0=__builtin_amdgcn_mfma_f32_32x32x16_bf16(kk,qr[d0],g0,0,0,0);}
    float gv[16];
    _Pragma("unroll") for(int r=0;r<8;++r){ const float mine=g0[r]; const float oth=__shfl_xor(mine,32); gv[(r&3)+8*(r>>2)]=hi?oth:mine; gv[(r&3)+8*(r>>2)+4]=hi?mine:oth; }
    _Pragma("unroll") for(int it=0;it<3;++it){ float best=-INFINITY; int bj=-1;
      _Pragma("unroll") for(int j=0;j<15;++j){ const bool ok=(j<qb)&&!((selmask>>j)&1u)&&(gv[j]>best); if(ok){best=gv[j];bj=j;} }
      if(bj>=0)selmask|=(1u<<bj); } }
  #define CMASK(P0,P1,t) do{ if((t)<4){ const float ad_=-mhat; _Pragma("unroll") for(int r=0;r<16;++r){P0[r]+=ad_;P1[r]+=ad_;} cmask(P0,P1,(t),qrel,hi);} \
    else { const float ad_=((selmask>>(((t)-4)>>2))&1u)?-mhat:-INFINITY; _Pragma("unroll") for(int r=0;r<16;++r){P0[r]+=ad_;P1[r]+=ad_;} } }while(0)
  bool resc=false;
  #define START(P0,P1) do{ const float rm=rowmax(P0,P1); resc=false; \
    { const float dl=rm; mhat=fadd_s(mhat,dl); \
      _Pragma("unroll") for(int r=0;r<16;++r){P0[r]=fsub_s(P0[r],dl);P1[r]=fsub_s(P1[r],dl);} \
      } \
    _Pragma("unroll") for(int r=0;r<16;++r)P0[r]=__builtin_amdgcn_exp2f(P0[r]); }while(0)
  #define RESC() do{ if(resc){ asm volatile("s_waitcnt lgkmcnt(0)":::"memory"); \
      _Pragma("unroll") for(int d_=0;d_<2;++d_) _Pragma("unroll") for(int r=0;r<16;++r)o[d_][r]*=wsf[crow(r,hi)]; } }while(0)
  f32x16 pA0,pA1,pB0,pB1;
  int sl_prev=0,sl_cur=0,sl_next=SLOTB;
  #define ROT() do{sl_prev=sl_cur;sl_cur=sl_next;sl_next=(sl_next==(NSLOT-1)*SLOTB)?0:sl_next+SLOTB;}while(0)
  DMA_K(2,2*SLOTB);
  WAIT_BAR(3);
  qkt(pA0,pA1,Kbase,qr,r32,hi);asm volatile("s_nop 15\n\ts_nop 7":"+v"(pA0),"+v"(pA1));CMASK(pA0,pA1,0);
  START(pA0,pA1);
  _Pragma("unroll") for(int r=0;r<16;++r)pA1[r]=__builtin_amdgcn_exp2f(pA1[r]);
  WAIT_BAR(0);
  DMA_K(3,0);DMA_V(1,SLOTB);
  ROT();
  kload8(kf,kp0+sl_cur);
  WAIT_BAR(2);
  s16x4 vlo[8],vhi[8]; u32x4 pw0,pw1,pw2,pw3;
  #define PKW(P,B) cvtpk_s(P[B],P[B+1])
  #define PAF(k) __builtin_bit_cast(bf16x8,pw##k)
  #define VFR(i) (bf16x8){vlo[i][0],vlo[i][1],vlo[i][2],vlo[i][3],vhi[i][0],vhi[i][1],vhi[i][2],vhi[i][3]}
  #define PIN(x) asm volatile("":"+v"(x))
  #define MX3(a,b,c) __builtin_fmaxf(__builtin_fmaxf((a),(b)),(c))
  #define GAPA(MF,A0,A1,A2,A3,W0,W1,PW) do{ MF; sacc+=A0; sacc+=A1; sacc+=A2; sacc+=A3; PIN(sacc); W0; W1; PIN(PW); SBAR(); }while(0)
  #define EX(v) __builtin_amdgcn_exp2f(v)
  #define GAPB(MF,X,B) do{ MF; X[B]=EX(X[B]); X[B+1]=EX(X[B+1]); X[B+2]=EX(X[B+2]); X[B+3]=EX(X[B+3]); PIN(X); SBAR(); }while(0)
  #define VRD(i) do{ vlo[i]=vtr(vp_+(((i)>>2)*4096+((i)&3)*1024)); vhi[i]=vtr(vp_+(((i)>>2)*4096+((i)&3)*1024+512)); }while(0)
  #define KRD(G,j) do{ if(G){ kload2(kf,kp0+sl_next,j); SBAR(); } }while(0)
  #define STEP(C0,C1,P0,P1,t,GK,GV,GL) do{ SBAR(); \
    const lds_cptr vp_=vp0+sl_prev; \
    VRD(0); SBAR(); float sacc=(P0[0]+P0[1]); \
    GAPA(C0=__builtin_amdgcn_mfma_f32_32x32x16_bf16(kf[0],qr[0],zero16,0,0,0), P0[2],P0[3],P0[4],P0[5],     pw0[0]=PKW(P0,0), pw0[1]=PKW(P0,2), pw0); \
    VRD(4); SBAR(); GAPA(C1=__builtin_amdgcn_mfma_f32_32x32x16_bf16(kf[1],qr[0],zero16,0,0,0), P0[6],P0[7],P0[8],P0[9],     pw0[2]=PKW(P0,4), pw0[3]=PKW(P0,6), pw0); \
    VRD(1); SBAR(); GAPA(C0=__builtin_amdgcn_mfma_f32_32x32x16_bf16(kf[2],qr[1],C0,0,0,0),   P0[10],P0[11],P0[12],P0[13], pw1[0]=PKW(P0,8), pw1[1]=PKW(P0,10), pw1); \
    VRD(5); SBAR(); GAPA(C1=__builtin_amdgcn_mfma_f32_32x32x16_bf16(kf[3],qr[1],C1,0,0,0),   P0[14],P0[15],P1[0],P1[1],   pw1[2]=PKW(P0,12),pw1[3]=PKW(P0,14), pw1); \
    VRD(2); SBAR(); GAPA(C0=__builtin_amdgcn_mfma_f32_32x32x16_bf16(kf[4],qr[2],C0,0,0,0),   P1[2],P1[3],P1[4],P1[5],     pw2[0]=PKW(P1,0), pw2[1]=PKW(P1,2), pw2); \
    VRD(6); SBAR(); GAPA(C1=__builtin_amdgcn_mfma_f32_32x32x16_bf16(kf[5],qr[2],C1,0,0,0),   P1[6],P1[7],P1[8],P1[9],     pw2[2]=PKW(P1,4), pw2[3]=PKW(P1,6), pw2); \
    VRD(3); SBAR(); GAPA(C0=__builtin_amdgcn_mfma_f32_32x32x16_bf16(kf[6],qr[3],C0,0,0,0),   P1[10],P1[11],P1[12],P1[13], pw3[0]=PKW(P1,8), pw3[1]=PKW(P1,10), pw3); \
    VRD(7); SBAR(); GAPA(C1=__builtin_amdgcn_mfma_f32_32x32x16_bf16(kf[7],qr[3],C1,0,0,0),   P1[14],P1[15],0.f,0.f,       pw3[2]=PKW(P1,12),pw3[3]=PKW(P1,14), pw3); \
    l_reg+=sacc; \
    if(GK){DMA_K((t)+3,sl_cur);} if(GV){DMA_V((t)+1,sl_next);} \
    CMASK(C0,C1,t); \
    { float a=MX3(C0[0],C0[1],C1[0]),b=MX3(C0[2],C0[3],C1[1]); a=MX3(a,C1[2],C1[3]); \
      _Pragma("unroll") for(int r=4;r<16;r+=4){a=MX3(a,C0[r],C0[r+1]);b=MX3(b,C0[r+2],C0[r+3]);a=MX3(a,C1[r],C1[r+1]);b=MX3(b,C1[r+2],C1[r+3]);} \
      float rm=__builtin_fmaxf(a,b); { auto rr=__builtin_amdgcn_permlane32_swap(__float_as_uint(rm),__float_as_uint(rm),false,false); rm=__builtin_fmaxf(__uint_as_float(rr[0]),__uint_as_float(rr[1])); } \
      resc=false; \
      if(__builtin_expect(__any(rm>(float)THRL),0)){ const float dl=__builtin_fmaxf(rm,0.f); mhat+=dl; \
        _Pragma("unroll") for(int r=0;r<16;++r){C0[r]-=dl;C1[r]-=dl;} \
        const float f=__builtin_amdgcn_exp2f(-dl); l_reg*=f; if(hi==0)wsf[r32]=f; resc=true; } } \
    SBAR(); \
    GAPB(o[0]=__builtin_amdgcn_mfma_f32_32x32x16_bf16(PAF(0),VFR(0),o[0],0,0,0), C0,0); \
    GAPB(o[1]=__builtin_amdgcn_mfma_f32_32x32x16_bf16(PAF(0),VFR(4),o[1],0,0,0), C0,4); \
    KRD(GL,0); GAPB(o[0]=__builtin_amdgcn_mfma_f32_32x32x16_bf16(PAF(1),VFR(1),o[0],0,0,0), C0,8); \
    KRD(GL,1); GAPB(o[1]=__builtin_amdgcn_mfma_f32_32x32x16_bf16(PAF(1),VFR(5),o[1],0,0,0), C0,12); \
    KRD(GL,2); GAPB(o[0]=__builtin_amdgcn_mfma_f32_32x32x16_bf16(PAF(2),VFR(2),o[0],0,0,0), C1,0); \
    KRD(GL,3); GAPB(o[1]=__builtin_amdgcn_mfma_f32_32x32x16_bf16(PAF(2),VFR(6),o[1],0,0,0), C1,4); \
    GAPB(o[0]=__builtin_amdgcn_mfma_f32_32x32x16_bf16(PAF(3),VFR(3),o[0],0,0,0), C1,8); \
    GAPB(o[1]=__builtin_amdgcn_mfma_f32_32x32x16_bf16(PAF(3),VFR(7),o[1],0,0,0), C1,12); \
    }while(0)
  int t=1;
  for(;t+5<NT;t+=2){
    STEP(pB0,pB1,pA0,pA1,t,true,true,true);     WAIT_BAR(2); RESC(); ROT();
    STEP(pA0,pA1,pB0,pB1,t+1,true,true,true);   WAIT_BAR(2); RESC(); ROT();
  }
  #define ENDW(tt) do{ if((tt)+3<NT){WAIT_BAR(2);} else if((tt)+2<NT){WAIT_BAR(1);} else {WAIT_BAR(0);} }while(0)
  for(;t+1<NT;t+=2){
    STEP(pB0,pB1,pA0,pA1,t,(t+3<NT),(t+1<NT),(t+1<NT));       ENDW(t);   RESC(); ROT();
    STEP(pA0,pA1,pB0,pB1,t+1,(t+4<NT),(t+2<NT),(t+2<NT));     ENDW(t+1); RESC(); ROT();
  }
  STEP(pB0,pB1,pA0,pA1,NT-1,false,false,false); RESC();
  { float sacc=pB0[0]+pB0[1]; _Pragma("unroll") for(int r=2;r<16;++r)sacc+=pB0[r]; _Pragma("unroll") for(int r=0;r<16;++r)sacc+=pB1[r]; l_reg+=sacc;
    pw0=(u32x4){PKW(pB0,0),PKW(pB0,2),PKW(pB0,4),PKW(pB0,6)};pw1=(u32x4){PKW(pB0,8),PKW(pB0,10),PKW(pB0,12),PKW(pB0,14)};pw2=(u32x4){PKW(pB1,0),PKW(pB1,2),PKW(pB1,4),PKW(pB1,6)};pw3=(u32x4){PKW(pB1,8),PKW(pB1,10),PKW(pB1,12),PKW(pB1,14)};
    SBAR(); pv(o,vb0+sl_cur,PAF(0),PAF(1),PAF(2),PAF(3)); }
  #undef PKW
  #undef PAF
  #undef VFR
  #undef PIN
  #undef MX3
  #undef GAPA
  #undef GAPB
  #undef EX
  #undef VRD
  #undef KRD
  #undef STEP
  #undef ENDW
  {auto rr=__builtin_amdgcn_permlane32_swap(__float_as_uint(l_reg),__float_as_uint(l_reg),false,false);l_reg=__uint_as_float(rr[0])+__uint_as_float(rr[1]);}
  if(hi==0)wsf[32+r32]=l_reg;asm volatile("s_waitcnt lgkmcnt(0)":::"memory");
  float rli[16];
  #pragma unroll
  for(int r=0;r<16;++r)rli[r]=__builtin_amdgcn_rcpf(wsf[32+crow(r,hi)]);
  bf16*Ow=O+(rowbase+q0+wid*QBLK)*DM+h*D;
  { bf16*stg=(bf16*)(shm+LDS_OST)+wid*2048;
    #pragma unroll
    for(int r=0;r<16;++r){const int orow=crow(r,hi);
      #pragma unroll
      for(int d0=0;d0<2;++d0)stg[orow*64+d0*32+r32]=__float2bfloat16(o[d0][r]*rli[r]);}
    asm volatile("s_waitcnt lgkmcnt(0)":::"memory");
    #pragma unroll
    for(int i=0;i<4;++i){const int row=i*8+(lane>>3),ch=lane&7; const u32x4 v=*(const u32x4*)(stg+row*64+ch*8); ATTN_STORE16(Ow+(long)row*DM+ch*8,v);} }
  asm volatile("s_waitcnt lgkmcnt(0)\n\ts_barrier":::"memory");
  #undef DMA_K
  #undef DMA_V
  #undef CMASK
  #undef START
  #undef RESC
  #undef ROT
}
constexpr int ATTN_LDS_BYTES=LDS_BYTES;
struct AttnTensors { const bf16* Q; const bf16* K; const bf16* V; bf16* O; const bf16* KM; };
struct AttnUnit { int bh; int qb; };
struct StaticOrder {
  int vcu;
  __device__ __forceinline__ explicit StaticOrder(int grid,int block):vcu((block%8)*(grid/8)+block/8){}
  __device__ __forceinline__ bool next(int i,AttnUnit&u)const{ if(i>=8)return false; const int s=(vcu&1)*4+(i>>1); u.bh=vcu>>1; u.qb=(i&1)?15-s:s; return true; }
  __device__ __forceinline__ void a_ready(const AttnUnit&)const{}
  __device__ __forceinline__ void done(const AttnUnit&)const{}
};
template<class Sched,int THRL=8> __device__ __forceinline__ void attn_phase(char*lds,const AttnTensors&T,const Sched&S){
  AttnUnit u;
  for(int i=0;S.next(i,u);++i){ S.a_ready(u); attn_unit<THRL>(u.bh/NHEAD,u.bh%NHEAD,u.qb,T.Q,T.K,T.V,T.O,T.KM,lds); S.done(u); }
}
#undef SBAR
#undef WAIT_BAR
}

constexpr int NWAVES = 8;
#ifndef MK_ONE_LAUNCH
#define MK_ONE_LAUNCH 0
#endif
constexpr int NPHASE = 15;

constexpr int D = DMODEL, SEQ = 4096, NB = 8;
constexpr int NIN = 7680;
constexpr float EPS = 1e-6f;
constexpr int NEXP = 32, MOE_ROWS = 73728;

constexpr size_t MiB = 1u << 20;
constexpr size_t WS_CTL = 0, CTL_ZERO_BYTES = 1 * MiB;
constexpr size_t WS_KM = 1 * MiB;
constexpr size_t WS_DEC = 1 * MiB + 512 * 1024;
constexpr size_t WS_ROUTE = 2 * MiB;
constexpr size_t WS_POS = 3 * MiB;
constexpr size_t WS_TILEE = 3 * MiB + 512 * 1024;
constexpr size_t WS_WR = 3 * MiB + 768 * 1024;
constexpr size_t WS_DT = 4 * MiB;
constexpr size_t WS_ROPE = 6 * MiB;
constexpr size_t WS_WIN = 16 * MiB;
constexpr size_t WS_WSA = 31 * MiB;
constexpr size_t WS_WO = 35 * MiB, WS_WPG = 37 * MiB, WS_WPLE = 39 * MiB;
constexpr size_t WS_WGU = 40 * MiB;
constexpr size_t WS_WD = 72 * MiB;
constexpr size_t WS_XN = 96 * MiB;
constexpr size_t WS_Z = 160 * MiB, WS_XS = 224 * MiB, WS_Q = 288 * MiB, WS_K = 352 * MiB, WS_V = 416 * MiB;
constexpr size_t WS_BC = 480 * MiB;
constexpr size_t WS_H2S = 160 * MiB;
constexpr size_t WS_HID = 352 * MiB;
constexpr size_t WS_PE = 416 * MiB;
constexpr size_t WS_END = 496 * MiB;
constexpr int CW_TMO = 0, CW_CODE = 1, CW_NTILES = 2;
constexpr int CW_BAR = 4096;
constexpr int CW_CNT = 16384;

constexpr int RING_OFF = 0, RING_BYTES = 131072;
constexpr int XT_PITCH = 136;
constexpr int SSD_XT = 0, SSD_XT_HEAD = 64 * XT_PITCH * 2;
constexpr int SSD_B = 4 * SSD_XT_HEAD;
constexpr int SSD_C = SSD_B + 18432;
constexpr int SSD_CB = SSD_C + 18432;
constexpr int SSD_ACUM = SSD_CB + 128 * XT_PITCH * 2;
constexpr int SSD_DTV = SSD_ACUM + 4096, SSD_SSQ = SSD_DTV + 4096;
constexpr int LDSCTL_OFF = SSD_SSQ + 4096;
constexpr int MISC_OFF = LDSCTL_OFF + 256;
constexpr int LDS_BYTES = 155648;
static_assert(MISC_OFF + 128 <= LDS_BYTES, "LDS map");

#define GAS __attribute__((address_space(1)))
#define LAS __attribute__((address_space(3)))
typedef unsigned short bf16;
typedef unsigned v4u __attribute__((ext_vector_type(4)));
typedef unsigned v2u __attribute__((ext_vector_type(2)));
typedef float f32x4 __attribute__((ext_vector_type(4)));
typedef float f32x16 __attribute__((ext_vector_type(16)));
typedef short bf16x8 __attribute__((ext_vector_type(8)));
typedef GAS unsigned gu32;
#define RLX_AGENT __ATOMIC_RELAXED, __HIP_MEMORY_SCOPE_AGENT
#define LDS_WAIT() asm volatile("s_waitcnt lgkmcnt(0)" ::: "memory")
#define VM_WAIT() asm volatile("s_waitcnt vmcnt(0)" ::: "memory")
__device__ __forceinline__ unsigned f2bf(float f) { unsigned u = __builtin_bit_cast(unsigned, f); return (u + 0x7fffu + ((u >> 16) & 1u)) >> 16; }
__device__ __forceinline__ unsigned pk2(float lo, float hi) { return pg8::cvt_pk_bf16(lo, hi); }
__device__ __forceinline__ float bflo(unsigned w) { return __builtin_bit_cast(float, w << 16); }
__device__ __forceinline__ float bfhi(unsigned w) { return __builtin_bit_cast(float, w & 0xffff0000u); }
__device__ __forceinline__ float silu_f(float x) { return x * __builtin_amdgcn_rcpf(1.0f + __expf(-x)); }

#define XB_TMO      128
#define XB_XCNT(j)  (256  + 64 * (j))
#define XB_XSUB(j)  (1280 + 64 * (j))
#define XB_XGEN(j)  (2304 + 64 * (j))
#define XB_TOP      3328
#define XB_TOPGEN   3392
#define XCD_BAR_WORDS 3456
#define XB_SPIN_CAP (1u << 18)

__device__ __forceinline__ unsigned xb_ld(unsigned* p)              { return __hip_atomic_load(p, __ATOMIC_RELAXED, __HIP_MEMORY_SCOPE_AGENT); }
__device__ __forceinline__ unsigned xb_add(unsigned* p, unsigned v) { return __hip_atomic_fetch_add(p, v, __ATOMIC_RELAXED, __HIP_MEMORY_SCOPE_AGENT); }
__device__ __forceinline__ unsigned xb_xcc_id() { return (unsigned)__builtin_amdgcn_s_getreg((3 << 11) | 20) & 0xFu; }
#define XB_SPIN(cond, bar) do { unsigned _sp = 0; while (cond) { __builtin_amdgcn_s_sleep(1); \
    if ((++_sp & 255u) == 0u) { if (xb_ld(&(bar)[XB_TMO])) break; if (_sp > XB_SPIN_CAP) { atomicAdd(&(bar)[XB_TMO], 1u); break; } } } } while (0)

struct XcdBarrier {
    unsigned* bar; unsigned x;
    volatile LAS unsigned* st;
};

__device__ __forceinline__ XcdBarrier xcd_barrier_post(unsigned* bar, volatile LAS unsigned* st) {
    XcdBarrier b; b.bar = bar; b.x = xb_xcc_id(); b.st = st;
    if (threadIdx.x == 0) (void)xb_add(&bar[XB_XCNT(b.x)], 1u);
    return b;
}
__device__ __forceinline__ void xcd_barrier_complete(unsigned* bar, unsigned x, unsigned& nloc, unsigned& nx) {
    const unsigned G = gridDim.x * gridDim.y * gridDim.z;
    unsigned sum, cnt, mine, sp = 0u;
    for (;;) {
        sum = 0u; cnt = 0u; mine = 0u;
#pragma unroll
        for (unsigned j = 0; j < 16; ++j) { const unsigned c = xb_ld(&bar[XB_XCNT(j)]); sum += c; cnt += (c > 0u) ? 1u : 0u; mine = (j == x) ? c : mine; }
        if (sum == G) break;
        __builtin_amdgcn_s_sleep(1);
        if ((++sp & 255u) == 0u) { if (xb_ld(&bar[XB_TMO])) break; if (sp > XB_SPIN_CAP) { atomicAdd(&bar[XB_TMO], 1u); break; } }
    }
    nloc = mine > 0u ? mine : 1u; nx = cnt > 0u ? cnt : 1u;
}

__device__ __forceinline__ void xcd_barrier(const XcdBarrier& b) {
    asm volatile("s_waitcnt vmcnt(0)" ::: "memory");
    __syncthreads();
    if (threadIdx.x == 0) {
        unsigned* bar = b.bar;
        __builtin_amdgcn_s_waitcnt(0);
        unsigned nloc = b.st[0], nx = b.st[1];
        if (nloc == 0u) { xcd_barrier_complete(bar, b.x, nloc, nx); b.st[0] = nloc; b.st[1] = nx; }
        const unsigned old = xb_add(&bar[XB_XSUB(b.x)], 1u);
        const unsigned gen = old / nloc;
        if (old + 1u == (gen + 1u) * nloc) {
            __builtin_amdgcn_fence(__ATOMIC_RELEASE, "agent");
            asm volatile("s_waitcnt vmcnt(0)" ::: "memory");
            const unsigned og = xb_add(&bar[XB_TOP], 1u);
            const unsigned tg = og / nx;
            if (og + 1u == (tg + 1u) * nx) xb_add(&bar[XB_TOPGEN], 1u);
            else XB_SPIN(xb_ld(&bar[XB_TOPGEN]) == tg, bar);
            __builtin_amdgcn_fence(__ATOMIC_ACQUIRE, "agent");
            xb_add(&bar[XB_XGEN(b.x)], 1u);
            asm volatile("s_waitcnt vmcnt(0)" ::: "memory");
        } else {
            XB_SPIN(xb_ld(&bar[XB_XGEN(b.x)]) == gen, bar);
            __builtin_amdgcn_fence(__ATOMIC_ACQUIRE, "agent");
            asm volatile("s_waitcnt vmcnt(0)" ::: "memory");
        }
    }
    __syncthreads();
}

struct Args {
    const float* x; const float* p; const int* positions; const float* attn_norm_w; const float* w_in; const float* conv_w; const float* conv_b;
    const float* dt_bias; const float* a_log; const float* d_skip; const float* ssd_norm_w; const float* w_ssd_out; const float* w_attn_out; const float* w_out;
    const float* moe_norm_w; const float* w_rg; const float* b_rg; const float* w_re; const float* b_re; const float* w_eg; const float* w_eu; const float* w_ed;
    const float* ple_norm_w; const float* w_ple; const float* w_pg; const float* final_norm_w;
    float* out; unsigned char* ws; int ph_lo, ph_hi;
};
struct Frame {
    LAS unsigned char* lds;
    volatile LAS unsigned* MISC;
    gu32* ctl;
    int tid, lane, wave;
    int vcu, G;
};

__device__ __forceinline__ float wave_sum(float v) {
#pragma unroll
    for (int o = 1; o < 64; o <<= 1) v += __shfl_xor(v, o);
    return v;
}
__device__ __forceinline__ float wave_incl_scan(float v, int lane) {
#pragma unroll
    for (int o = 1; o < 64; o <<= 1) { const float t = __shfl_up(v, o); if (lane >= o) v += t; }
    return v;
}

enum { MAP_ID = 0, MAP_WIN = 1, MAP_GATE = 2, MAP_UP = 3 };
__device__ __forceinline__ int dst_row(int mode, int n) {
    if (mode == MAP_WIN) {
        if (n < 2048) return n;
        if (n < 2304) return 7168 + (n - 2048);
        if (n < 2320) return 7424 + (n - 2304);
        if (n < 4368) { const int j = (n - 2320) & 1023, isk = (n - 2320) >> 10; const int h = j >> 6, d = j & 63; const int pos = d < 32 ? 2 * d : 2 * (d - 32) + 1; return 2048 + isk * 1024 + h * 64 + pos; }
        return n - 4368 + 4096;
    }
    if (mode == MAP_GATE) return (n >> 7) * 256 + (n & 127);
    if (mode == MAP_UP) return (n >> 7) * 256 + 128 + (n & 127);
    return n;
}
__device__ __forceinline__ void p0_transpose_item(const float* W, int K, int N, bf16* WT, int mode, LAS float* scr, int item, int lane) {
    const int nblk = (N + 31) / 32, kb = item / nblk, nb = item % nblk, k0 = 64 * kb, n0 = 32 * nb;
    const bool nok = (n0 + (lane & 31)) < N;
#pragma unroll 8
    for (int i = 0; i < 32; ++i) { const int kk = 2 * i + (lane >> 5); scr[kk * 33 + (lane & 31)] = nok ? W[(size_t)(k0 + kk) * N + n0 + (lane & 31)] : 0.f; }
    LDS_WAIT(); asm volatile("" ::: "memory");
    const int c = lane & 7;
#pragma unroll
    for (int j = 0; j < 4; ++j) { const int n = (lane >> 3) + 8 * j; const LAS float* s = scr + (8 * c) * 33 + n;
        v4u o; o.x = pk2(s[0 * 33], s[1 * 33]); o.y = pk2(s[2 * 33], s[3 * 33]); o.z = pk2(s[4 * 33], s[5 * 33]); o.w = pk2(s[6 * 33], s[7 * 33]);
        if (n0 + n < N) *(GAS v4u*)(WT + (size_t)dst_row(mode, n0 + n) * K + k0 + 8 * c) = o; }
    LDS_WAIT(); asm volatile("" ::: "memory");
}
__device__ __forceinline__ void rms_row_to_bf16(const float* xrow, const float* w, bf16* orow, int lane) {
    const GAS f32x4* xr = (const GAS f32x4*)xrow + lane; const GAS f32x4* wr = (const GAS f32x4*)w + lane;
    f32x4 v[4]; float s = 0.f;
#pragma unroll
    for (int j = 0; j < 4; ++j) { v[j] = xr[64 * j]; s += (v[j].x * v[j].x + v[j].y * v[j].y) + (v[j].z * v[j].z + v[j].w * v[j].w); }
    const float inv = 1.0f / sqrtf(wave_sum(s) * (1.f / D) + EPS);
    GAS v2u* o8 = (GAS v2u*)orow + lane;
#pragma unroll
    for (int j = 0; j < 4; ++j) { const f32x4 ww = wr[64 * j]; v2u o; o.x = pk2(v[j].x * inv * ww.x, v[j].y * inv * ww.y); o.y = pk2(v[j].z * inv * ww.z, v[j].w * inv * ww.w); o8[64 * j] = o; }
}
__device__ __forceinline__ void p0_prologue(const Frame& F, const Args& a) {
    unsigned char* ws = a.ws;
    LAS float* scr = (LAS float*)(F.lds + RING_OFF + F.wave * 16384);
    const int gw = F.vcu * NWAVES + F.wave, NGW = F.G * NWAVES;
    constexpr int I_IN = 16 * 233, I_SQ = 16 * 32, I_PLE = 4 * 32, I_GU = 16 * 8, I_DN = 4 * 32;
    constexpr int NITEMS = I_IN + 4 * I_SQ + I_PLE + 32 * (2 * I_GU + I_DN);
    for (int it = gw; it < NITEMS; it += NGW) {
        int r = it;
        if (r < I_IN) { p0_transpose_item(a.w_in, 1024, 7440, (bf16*)(ws + WS_WIN), MAP_WIN, scr, r, F.lane); continue; } r -= I_IN;
        if (r < I_SQ) { p0_transpose_item(a.w_ssd_out, 1024, 1024, (bf16*)(ws + WS_WSA), MAP_ID, scr, r, F.lane); continue; } r -= I_SQ;
        if (r < I_SQ) { p0_transpose_item(a.w_attn_out, 1024, 1024, (bf16*)(ws + WS_WSA) + 1024 * 1024, MAP_ID, scr, r, F.lane); continue; } r -= I_SQ;
        if (r < I_SQ) { p0_transpose_item(a.w_out, 1024, 1024, (bf16*)(ws + WS_WO), MAP_ID, scr, r, F.lane); continue; } r -= I_SQ;
        if (r < I_SQ) { p0_transpose_item(a.w_pg, 1024, 1024, (bf16*)(ws + WS_WPG), MAP_ID, scr, r, F.lane); continue; } r -= I_SQ;
        if (r < I_PLE) { p0_transpose_item(a.w_ple, 256, 1024, (bf16*)(ws + WS_WPLE), MAP_ID, scr, r, F.lane); continue; } r -= I_PLE;
        const int e = r / (2 * I_GU + I_DN); r -= e * (2 * I_GU + I_DN);
        if (r < I_GU) { p0_transpose_item(a.w_eg + (size_t)e * 1024 * 256, 1024, 256, (bf16*)(ws + WS_WGU) + (size_t)e * 512 * 1024, MAP_GATE, scr, r, F.lane); continue; } r -= I_GU;
        if (r < I_GU) { p0_transpose_item(a.w_eu + (size_t)e * 1024 * 256, 1024, 256, (bf16*)(ws + WS_WGU) + (size_t)e * 512 * 1024, MAP_UP, scr, r, F.lane); continue; } r -= I_GU;
        p0_transpose_item(a.w_ed + (size_t)e * 256 * 1024, 256, 1024, (bf16*)(ws + WS_WD) + (size_t)e * 1024 * 256, MAP_ID, scr, r, F.lane);
    }
    { bf16* wr = (bf16*)(ws + WS_WR); const int gt = gw * 64 + F.lane, NGT = NGW * 64;
      for (int i = gt; i < 64 * 1024; i += NGT) { const int j = i >> 10, k = i & 1023; float v = 0.f; if (j < 4) v = a.w_rg[k * 4 + j]; else if (j < 36) v = a.w_re[k * 32 + (j - 4)]; wr[i] = (bf16)f2bf(v); } }
    { float* rp = (float*)(ws + WS_ROPE); const int gt = gw * 64 + F.lane, NGT = NGW * 64;
      for (int i = gt; i < M_TOK * 32; i += NGT) { const int row = i >> 5, fi = i & 31; const float inv = powf(10000.0f, -(float)fi / 32.0f); const float ang = (float)a.positions[row] * inv;
          double t = (double)ang * 0.15915494309189535; t -= rint(t); const float fr = (float)t;
          rp[2 * i] = __builtin_amdgcn_cosf(fr); rp[2 * i + 1] = __builtin_amdgcn_sinf(fr); } }
#ifdef DEBUG_X1_IS_X
    for (int m = gw; m < M_TOK; m += NGW) { const GAS f32x4* xr = (const GAS f32x4*)(a.x + (size_t)m * D) + F.lane; GAS f32x4* orow = (GAS f32x4*)(a.out + (size_t)m * D) + F.lane; for (int j = 0; j < 4; ++j) orow[64 * j] = xr[64 * j]; }
#endif
    for (int m = gw; m < M_TOK; m += NGW) rms_row_to_bf16(a.x + (size_t)m * D, a.attn_norm_w, (bf16*)(ws + WS_XN) + (size_t)m * D, F.lane);
}

template <bool SCALE>
__device__ __forceinline__ void conv64_T(const bf16* src, int pitch, bool first_chunk, const float* cw, const float* cb, LAS bf16* dst, const LAS float* sc, int u) {
    const int cg = u & 7, tg = u >> 3;
    float w[4][8], bb[8];
#pragma unroll
    for (int k = 0; k < 4; ++k) { const f32x4 a0 = *(const f32x4*)(cw + k * 1280 + cg * 8), a1 = *(const f32x4*)(cw + k * 1280 + cg * 8 + 4);
        w[k][0] = a0.x; w[k][1] = a0.y; w[k][2] = a0.z; w[k][3] = a0.w; w[k][4] = a1.x; w[k][5] = a1.y; w[k][6] = a1.z; w[k][7] = a1.w; }
    { const f32x4 a0 = *(const f32x4*)(cb + cg * 8), a1 = *(const f32x4*)(cb + cg * 8 + 4); bb[0] = a0.x; bb[1] = a0.y; bb[2] = a0.z; bb[3] = a0.w; bb[4] = a1.x; bb[5] = a1.y; bb[6] = a1.z; bb[7] = a1.w; }
    v4u in[11];
#pragma unroll
    for (int j = 0; j < 11; ++j) { const int tok = tg * 8 - 3 + j; in[j] = (first_chunk && tok < 0) ? (v4u){0u, 0u, 0u, 0u} : *(const v4u*)(src + (long)tok * pitch + cg * 8); }
    unsigned outp[8][4];
#pragma unroll
    for (int j = 0; j < 8; ++j) {
        float o[8];
#pragma unroll
        for (int i = 0; i < 8; ++i) o[i] = bb[i];
#pragma unroll
        for (int k = 0; k < 4; ++k) { const v4u q = in[j + k];
            o[0] += w[k][0] * bflo(q.x); o[1] += w[k][1] * bfhi(q.x); o[2] += w[k][2] * bflo(q.y); o[3] += w[k][3] * bfhi(q.y);
            o[4] += w[k][4] * bflo(q.z); o[5] += w[k][5] * bfhi(q.z); o[6] += w[k][6] * bflo(q.w); o[7] += w[k][7] * bfhi(q.w); }
        const float s = SCALE ? sc[tg * 8 + j] : 1.0f;
#pragma unroll
        for (int i = 0; i < 8; ++i) { const float v = silu_f(o[i]) * s; const unsigned b = f2bf(v);
            if (j & 1) outp[i][j >> 1] |= b << 16; else outp[i][j >> 1] = b; }
    }
#pragma unroll
    for (int i = 0; i < 8; ++i) *(LAS v4u*)(dst + (cg * 8 + i) * XT_PITCH + tg * 8) = (v4u){outp[i][0], outp[i][1], outp[i][2], outp[i][3]};
}
__device__ __forceinline__ void conv64_N(const bf16* src, int pitch, bool first_chunk, const float* cw, const float* cb, LAS bf16* dst, int t) {
    const int l = t >> 2, c16 = (t & 3) * 16;
    float o[16];
#pragma unroll
    for (int i = 0; i < 16; i += 4) { const f32x4 b4 = *(const f32x4*)(cb + c16 + i); o[i] = b4.x; o[i + 1] = b4.y; o[i + 2] = b4.z; o[i + 3] = b4.w; }
#pragma unroll
    for (int k = 0; k < 4; ++k) { const int tok = l - 3 + k;
        v4u q0 = {0u, 0u, 0u, 0u}, q1 = {0u, 0u, 0u, 0u};
        if (!(first_chunk && tok < 0)) { q0 = *(const v4u*)(src + (long)tok * pitch + c16); q1 = *(const v4u*)(src + (long)tok * pitch + c16 + 8); }
        float wv[16];
#pragma unroll
        for (int i = 0; i < 16; i += 4) { const f32x4 w4 = *(const f32x4*)(cw + k * 1280 + c16 + i); wv[i] = w4.x; wv[i + 1] = w4.y; wv[i + 2] = w4.z; wv[i + 3] = w4.w; }
        o[0] += wv[0] * bflo(q0.x); o[1] += wv[1] * bfhi(q0.x); o[2] += wv[2] * bflo(q0.y); o[3] += wv[3] * bfhi(q0.y); o[4] += wv[4] * bflo(q0.z); o[5] += wv[5] * bfhi(q0.z); o[6] += wv[6] * bflo(q0.w); o[7] += wv[7] * bfhi(q0.w);
        o[8] += wv[8] * bflo(q1.x); o[9] += wv[9] * bfhi(q1.x); o[10] += wv[10] * bflo(q1.y); o[11] += wv[11] * bfhi(q1.y); o[12] += wv[12] * bflo(q1.z); o[13] += wv[13] * bfhi(q1.z); o[14] += wv[14] * bflo(q1.w); o[15] += wv[15] * bfhi(q1.w); }
#pragma unroll
    for (int i = 0; i < 16; ++i) o[i] = silu_f(o[i]);
    *(LAS v4u*)(dst + l * 72 + c16) = (v4u){pk2(o[0], o[1]), pk2(o[2], o[3]), pk2(o[4], o[5]), pk2(o[6], o[7])};
    *(LAS v4u*)(dst + l * 72 + c16 + 8) = (v4u){pk2(o[8], o[9]), pk2(o[10], o[11]), pk2(o[12], o[13]), pk2(o[14], o[15])};
}
template <bool WEIGHT>
__device__ __forceinline__ float ssd_dt_scan(const float* dtb, long tok0, int h, float Ah, LAS float* acum, LAS float* aux, int lane) {
    const float d0 = dtb[(tok0 + lane) * 16 + h], d1 = dtb[(tok0 + lane + 64) * 16 + h];
    const float s0 = wave_incl_scan(d0 * Ah, lane); const float t0 = __shfl(s0, 63);
    const float s1 = wave_incl_scan(d1 * Ah, lane) + t0; const float tot = __shfl(s1, 63);
    acum[lane] = s0; acum[lane + 64] = s1;
    if (WEIGHT) { aux[lane] = __expf(tot - s0) * d0; aux[lane + 64] = __expf(tot - s1) * d1; } else { aux[lane] = d0; aux[lane + 64] = d1; }
    return tot;
}

__device__ __forceinline__ void ssd_states_unit(const Frame& F, const Args& a, int unit) {
    unsigned char* ws = a.ws;
    const int g = unit & 1, c = (unit >> 1) & 31, b = unit >> 6; const long tok0 = (long)b * SEQ + c * 128; const bool first = (c == 0);
    const bf16* XS = (const bf16*)(ws + WS_XS); const bf16* BC = (const bf16*)(ws + WS_BC); const float* DT = (const float*)(ws + WS_DT);
    float* ST = (float*)(ws + WS_XN); float* DEC = (float*)(ws + WS_DEC);
    LAS float* acum = (LAS float*)(F.lds + SSD_ACUM); LAS float* wl = (LAS float*)(F.lds + SSD_DTV);
    int tid = F.tid; asm volatile("" : "+v"(tid));
    const int w = __builtin_amdgcn_readfirstlane(tid >> 6), lane = tid & 63;
    { const int h = g * 8 + w; const float Ah = -__expf(a.a_log[h]); const float tot = ssd_dt_scan<true>(DT, tok0, h, Ah, acum + w * 128, wl + w * 128, lane);
      if (lane == 0) DEC[(b * 32 + c) * 16 + h] = __expf(tot); }
    if (tid < 128) conv64_T<false>(BC + tok0 * 256 + g * 64, 256, first, a.conv_w + 1024 + g * 64, a.conv_b + 1024 + g * 64, (LAS bf16*)(F.lds + SSD_B), nullptr, tid);
    __syncthreads();
#pragma unroll 1
    for (int rnd = 0; rnd < 2; ++rnd) {
        const int hl = w >> 1, e = rnd * 4 + hl, h = g * 8 + e, ph = w & 1;
        conv64_T<true>(XS + tok0 * 1024 + h * 64, 1024, first, a.conv_w + h * 64, a.conv_b + h * 64, (LAS bf16*)(F.lds + SSD_XT + hl * SSD_XT_HEAD), wl + e * 128, tid & 127);
        __syncthreads();
        const LAS bf16* xt = (const LAS bf16*)(F.lds + SSD_XT + hl * SSD_XT_HEAD); const LAS bf16* bt = (const LAS bf16*)(F.lds + SSD_B);
        const int r = lane & 31, kh = lane >> 5;
        f32x16 acc[2]; acc[0] = f32x16{}; acc[1] = f32x16{};
#pragma unroll
        for (int ks = 0; ks < 8; ++ks) {
            const bf16x8 af = *(const LAS bf16x8*)(xt + (32 * ph + r) * XT_PITCH + 16 * ks + 8 * kh);
#pragma unroll
            for (int nt = 0; nt < 2; ++nt) { const bf16x8 bf = *(const LAS bf16x8*)(bt + (32 * nt + r) * XT_PITCH + 16 * ks + 8 * kh); acc[nt] = __builtin_amdgcn_mfma_f32_32x32x16_bf16(af, bf, acc[nt], 0, 0, 0); }
        }
        float* so = ST + ((size_t)((b * 32 + c) * 16 + h)) * 4096;
#pragma unroll
        for (int nt = 0; nt < 2; ++nt)
#pragma unroll
            for (int rg = 0; rg < 16; ++rg) { const int p = 32 * ph + (rg & 3) + 8 * (rg >> 2) + 4 * kh; so[p * 64 + 32 * nt + r] = acc[nt][rg]; }
        __syncthreads();
    }
}
__device__ __forceinline__ void kmean_unit(const Frame& F, const Args& a, int unit) {
    const bf16* Kb = (const bf16*)(a.ws + WS_K); bf16* KM = (bf16*)(a.ws + WS_KM);
    const int b = unit >> 4, blk = unit & 15; const unsigned* src = (const unsigned*)(Kb + ((size_t)b * SEQ + blk * 256) * 1024) + F.tid;
    float s0 = 0.f, s1 = 0.f;
#pragma unroll 8
    for (int r = 0; r < 256; ++r) { const unsigned v = src[(size_t)r * 512]; s0 += bflo(v); s1 += bfhi(v); }
    const int h = F.tid >> 5, d = (2 * F.tid) & 63;
    *(unsigned*)(KM + ((size_t)(b * 16 + h) * 16 + blk) * 64 + d) = pk2(s0 * (1.f / 256.f), s1 * (1.f / 256.f));
}
__device__ __forceinline__ void ssd_scan(const Frame& F, const Args& a) {
    float* ST = (float*)(a.ws + WS_XN); const float* DEC = (const float*)(a.ws + WS_DEC);
    const int gt = (F.vcu * NWAVES + F.wave) * 64 + F.lane, NGT = F.G * NWAVES * 64;
    for (int i = gt; i < NB * 16 * 1024; i += NGT) {
        const int bh = i >> 10, e4 = i & 1023, b = bh >> 4, h = bh & 15;
        f32x4 st = {0.f, 0.f, 0.f, 0.f};
#pragma unroll 8
        for (int c = 0; c < 32; ++c) { f32x4* pp = (f32x4*)(ST + ((size_t)((b * 32 + c) * 16 + h)) * 4096) + e4; const f32x4 s = *pp; const float d = DEC[(b * 32 + c) * 16 + h]; *pp = st; st = st * d + s; }
    }
}
__device__ __forceinline__ int stg_off(int l, int p) { return l * 64 + ((((p >> 3) ^ (l & 7)) << 3) | (p & 7)); }
__device__ __forceinline__ void ssd_out_unit(const Frame& F, const Args& a, int unit) {
    unsigned char* ws = a.ws;
    const int g = unit & 1, c = (unit >> 1) & 31, b = unit >> 6; const long tok0 = (long)b * SEQ + c * 128; const bool first = (c == 0);
    const bf16* XS = (const bf16*)(ws + WS_XS); const bf16* BC = (const bf16*)(ws + WS_BC); const float* DT = (const float*)(ws + WS_DT);
    const float* PREV = (const float*)(ws + WS_XN); bf16* ZY = (bf16*)(ws + WS_Z);
    LAS float* acum = (LAS float*)(F.lds + SSD_ACUM); LAS float* dtv = (LAS float*)(F.lds + SSD_DTV); LAS float* ssq = (LAS float*)(F.lds + SSD_SSQ);
    LAS bf16* BL = (LAS bf16*)(F.lds + SSD_B); LAS bf16* CL = (LAS bf16*)(F.lds + SSD_C); LAS bf16* CBL = (LAS bf16*)(F.lds + SSD_CB);
    int tid = F.tid; asm volatile("" : "+v"(tid));
    const int w = __builtin_amdgcn_readfirstlane(tid >> 6), lane = tid & 63, r = lane & 31, kh = lane >> 5;
    { const int h = g * 8 + w; const float Ah = -__expf(a.a_log[h]); (void)ssd_dt_scan<false>(DT, tok0, h, Ah, acum + w * 128, dtv + w * 128, lane); }
    conv64_N(BC + tok0 * 256 + g * 64, 256, first, a.conv_w + 1024 + g * 64, a.conv_b + 1024 + g * 64, BL, tid);
    conv64_N(BC + tok0 * 256 + 128 + g * 64, 256, first, a.conv_w + 1152 + g * 64, a.conv_b + 1152 + g * 64, CL, tid);
    __syncthreads();
    { const int tl = w >> 1;
#pragma unroll
      for (int q = 0; q < 2; ++q) { const int ts = (w & 1) * 2 + q;
        if (ts <= tl) { f32x16 cacc = f32x16{};
#pragma unroll
            for (int ks = 0; ks < 4; ++ks) { const bf16x8 af = *(const LAS bf16x8*)(BL + (32 * ts + r) * 72 + 16 * ks + 8 * kh); const bf16x8 bf = *(const LAS bf16x8*)(CL + (32 * tl + r) * 72 + 16 * ks + 8 * kh);
                cacc = __builtin_amdgcn_mfma_f32_32x32x16_bf16(af, bf, cacc, 0, 0, 0); }
#pragma unroll
            for (int gq = 0; gq < 4; ++gq) *(LAS v2u*)(CBL + (32 * tl + r) * XT_PITCH + 32 * ts + 8 * gq + 4 * kh) = (v2u){pk2(cacc[4 * gq], cacc[4 * gq + 1]), pk2(cacc[4 * gq + 2], cacc[4 * gq + 3])}; } } }
#pragma unroll
    for (int rnd = 0; rnd < 2; ++rnd) {
        const int hl = w >> 1, e = rnd * 4 + hl, h = g * 8 + e, lh = w & 1;
        LAS bf16* xt = (LAS bf16*)(F.lds + SSD_XT + hl * SSD_XT_HEAD);
        conv64_T<false>(XS + tok0 * 1024 + h * 64, 1024, first, a.conv_w + h * 64, a.conv_b + h * 64, xt, nullptr, tid & 127);
        __syncthreads();
        const float Dh = a.d_skip[h];
        const LAS float* ac = acum + e * 128; const LAS float* dv = dtv + e * 128;
        const float* pv = PREV + ((size_t)((b * 32 + c) * 16 + h)) * 4096;
        f32x16 acc[2][2];
#pragma unroll
        for (int pt = 0; pt < 2; ++pt)
#pragma unroll
            for (int lt = 0; lt < 2; ++lt) acc[pt][lt] = f32x16{};
#pragma unroll
        for (int lt = 0; lt < 2; ++lt) {
            const int L = 2 * lh + lt, lcol = 32 * L + r; const float al = ac[lcol];
#pragma unroll 1
            for (int ks = 0; ks < 2 * (L + 1); ++ks) {
                const int s0 = 16 * ks + 8 * kh;
                const v4u cb = *(const LAS v4u*)(CBL + lcol * XT_PITCH + s0);
                const f32x4 a0 = *(const LAS f32x4*)(ac + s0), a1 = *(const LAS f32x4*)(ac + s0 + 4), d0 = *(const LAS f32x4*)(dv + s0), d1 = *(const LAS f32x4*)(dv + s0 + 4);
                float mv[8];
                mv[0] = bflo(cb.x) * __expf(al - a0.x) * d0.x; mv[1] = bfhi(cb.x) * __expf(al - a0.y) * d0.y; mv[2] = bflo(cb.y) * __expf(al - a0.z) * d0.z; mv[3] = bfhi(cb.y) * __expf(al - a0.w) * d0.w;
                mv[4] = bflo(cb.z) * __expf(al - a1.x) * d1.x; mv[5] = bfhi(cb.z) * __expf(al - a1.y) * d1.y; mv[6] = bflo(cb.w) * __expf(al - a1.z) * d1.z; mv[7] = bfhi(cb.w) * __expf(al - a1.w) * d1.w;
#pragma unroll
                for (int j = 0; j < 8; ++j) { const int s = s0 + j; mv[j] = (s <= lcol) ? mv[j] : 0.f; if (s == lcol) mv[j] += Dh; }
                const v4u mp = {pk2(mv[0], mv[1]), pk2(mv[2], mv[3]), pk2(mv[4], mv[5]), pk2(mv[6], mv[7])}; const bf16x8 mf = __builtin_bit_cast(bf16x8, mp);
#pragma unroll
                for (int pt = 0; pt < 2; ++pt) { const bf16x8 xf = *(const LAS bf16x8*)(xt + (32 * pt + r) * XT_PITCH + s0); acc[pt][lt] = __builtin_amdgcn_mfma_f32_32x32x16_bf16(xf, mf, acc[pt][lt], 0, 0, 0); }
            }
            const float ea = __expf(al);
#pragma unroll
            for (int ks = 0; ks < 4; ++ks) { const int n0 = 16 * ks + 8 * kh;
                const v4u cq = *(const LAS v4u*)(CL + lcol * 72 + n0);
                const v4u cp = {pk2(bflo(cq.x) * ea, bfhi(cq.x) * ea), pk2(bflo(cq.y) * ea, bfhi(cq.y) * ea), pk2(bflo(cq.z) * ea, bfhi(cq.z) * ea), pk2(bflo(cq.w) * ea, bfhi(cq.w) * ea)}; const bf16x8 cf = __builtin_bit_cast(bf16x8, cp);
#pragma unroll
                for (int pt = 0; pt < 2; ++pt) { const f32x4 p0 = *(const f32x4*)(pv + (32 * pt + r) * 64 + n0), p1 = *(const f32x4*)(pv + (32 * pt + r) * 64 + n0 + 4);
                    const v4u pp = {pk2(p0.x, p0.y), pk2(p0.z, p0.w), pk2(p1.x, p1.y), pk2(p1.z, p1.w)}; acc[pt][lt] = __builtin_amdgcn_mfma_f32_32x32x16_bf16(__builtin_bit_cast(bf16x8, pp), cf, acc[pt][lt], 0, 0, 0); } }
        }
        __syncthreads();
#pragma unroll
        for (int pt = 0; pt < 2; ++pt)
#pragma unroll
            for (int lt = 0; lt < 2; ++lt) { const int l = 32 * (2 * lh + lt) + r;
#pragma unroll
                for (int gq = 0; gq < 4; ++gq) { const int p0 = 32 * pt + 8 * gq + 4 * kh; *(LAS v2u*)(xt + stg_off(l, p0)) = (v2u){pk2(acc[pt][lt][4 * gq], acc[pt][lt][4 * gq + 1]), pk2(acc[pt][lt][4 * gq + 2], acc[pt][lt][4 * gq + 3])}; } }
        LDS_WAIT(); asm volatile("" ::: "memory");
        const int lr = lane >> 3, cg = lane & 7;
#pragma unroll
        for (int i = 0; i < 8; ++i) { const int l = lh * 64 + lr + 8 * i;
            const v4u yv = *(const LAS v4u*)(xt + stg_off(l, cg * 8)); const v4u zv = *(const v4u*)(ZY + (tok0 + l) * 1024 + h * 64 + cg * 8);
            float y[8];
            y[0] = bflo(yv.x) * silu_f(bflo(zv.x)); y[1] = bfhi(yv.x) * silu_f(bfhi(zv.x)); y[2] = bflo(yv.y) * silu_f(bflo(zv.y)); y[3] = bfhi(yv.y) * silu_f(bfhi(zv.y));
            y[4] = bflo(yv.z) * silu_f(bflo(zv.z)); y[5] = bfhi(yv.z) * silu_f(bfhi(zv.z)); y[6] = bflo(yv.w) * silu_f(bflo(zv.w)); y[7] = bfhi(yv.w) * silu_f(bfhi(zv.w));
            float sq = (y[0] * y[0] + y[1] * y[1]) + (y[2] * y[2] + y[3] * y[3]) + (y[4] * y[4] + y[5] * y[5]) + (y[6] * y[6] + y[7] * y[7]);
            sq += __shfl_xor(sq, 1); sq += __shfl_xor(sq, 2); sq += __shfl_xor(sq, 4);
            if (cg == 0) ssq[e * 128 + l] = sq;
            *(v4u*)(ZY + (tok0 + l) * 1024 + h * 64 + cg * 8) = (v4u){pk2(y[0], y[1]), pk2(y[2], y[3]), pk2(y[4], y[5]), pk2(y[6], y[7])}; }
        __syncthreads();
    }
    { const int lh = w & 1, lr = lane >> 3, cg = lane & 7;
#pragma unroll
      for (int rnd = 0; rnd < 2; ++rnd) { const int e = rnd * 4 + (w >> 1), h = g * 8 + e;
        const f32x4 nw0 = *(const f32x4*)(a.ssd_norm_w + h * 64 + cg * 8), nw1 = *(const f32x4*)(a.ssd_norm_w + h * 64 + cg * 8 + 4);
#pragma unroll
        for (int i = 0; i < 8; ++i) { const int l = lh * 64 + lr + 8 * i;
            float s = 0.f;
#pragma unroll
            for (int q = 0; q < 8; ++q) s += ssq[q * 128 + l];
            const float inv = 1.0f / sqrtf(s * (1.f / 512.f) + EPS); const v4u yv = *(const v4u*)(ZY + (tok0 + l) * 1024 + h * 64 + cg * 8);
            const v4u o = {pk2(bflo(yv.x) * inv * nw0.x, bfhi(yv.x) * inv * nw0.y), pk2(bflo(yv.y) * inv * nw0.z, bfhi(yv.y) * inv * nw0.w), pk2(bflo(yv.z) * inv * nw1.x, bfhi(yv.z) * inv * nw1.y), pk2(bflo(yv.w) * inv * nw1.z, bfhi(yv.w) * inv * nw1.w)};
            *(v4u*)(ZY + (tok0 + l) * 1024 + h * 64 + cg * 8) = o; } } }
    __syncthreads();
}

constexpr int RT_PITCH = 1032;
__device__ __forceinline__ void moe_route_block(const Frame& F, const Args& a, int blk) {
    unsigned char* ws = a.ws;
    LAS bf16* tile = (LAS bf16*)(F.lds); LAS float* part = (LAS float*)(F.lds + 32 * RT_PITCH * 2);
    const int w = F.wave, lane = F.lane; const long row0 = (long)blk * 32;
    bf16* H2 = (bf16*)(ws + WS_XN);
#pragma unroll 1
    for (int q = 0; q < 4; ++q) { const int rl = w * 4 + q; const float* xrow = a.out + (row0 + rl) * D;
        const GAS f32x4* xr = (const GAS f32x4*)xrow + lane; const GAS f32x4* wr = (const GAS f32x4*)a.moe_norm_w + lane;
        f32x4 v[4]; float s = 0.f;
#pragma unroll
        for (int j = 0; j < 4; ++j) { v[j] = xr[64 * j]; s += (v[j].x * v[j].x + v[j].y * v[j].y) + (v[j].z * v[j].z + v[j].w * v[j].w); }
        const float inv = 1.0f / sqrtf(wave_sum(s) * (1.f / D) + EPS);
#pragma unroll
        for (int j = 0; j < 4; ++j) { const f32x4 ww = wr[64 * j]; v2u o; o.x = pk2(v[j].x * inv * ww.x, v[j].y * inv * ww.y); o.y = pk2(v[j].z * inv * ww.z, v[j].w * inv * ww.w);
            ((GAS v2u*)(H2 + (row0 + rl) * D) + lane)[64 * j] = o; *(LAS v2u*)(tile + rl * RT_PITCH + 4 * lane + 256 * j) = o; } }
    __syncthreads();
    { const int ct = w & 1, kq = w >> 1, r = lane & 31, kh = lane >> 5; const bf16* WR = (const bf16*)(ws + WS_WR);
      f32x16 acc = f32x16{};
#pragma unroll 4
      for (int ks = 0; ks < 16; ++ks) { const int k0 = 256 * kq + 16 * ks + 8 * kh;
          const bf16x8 af = *(const LAS bf16x8*)(tile + r * RT_PITCH + k0); const bf16x8 bf = *(const bf16x8*)(WR + (size_t)(32 * ct + r) * 1024 + k0);
          acc = __builtin_amdgcn_mfma_f32_32x32x16_bf16(af, bf, acc, 0, 0, 0); }
#pragma unroll
      for (int rg = 0; rg < 16; ++rg) part[(kq * 32 + (rg & 3) + 8 * (rg >> 2) + 4 * kh) * 64 + 32 * ct + r] = acc[rg]; }
    __syncthreads();
    if (F.tid < 32) { const int rl = F.tid; const LAS float* p0 = part + rl * 64;
        float gl[4];
#pragma unroll
        for (int j = 0; j < 4; ++j) gl[j] = (p0[j] + p0[2048 + j]) + (p0[4096 + j] + p0[6144 + j]) + a.b_rg[j];
        int gi = 0; float gm = gl[0];
#pragma unroll
        for (int j = 1; j < 4; ++j) if (gl[j] > gm) { gm = gl[j]; gi = j; }
        float den = 0.f;
#pragma unroll
        for (int j = 0; j < 4; ++j) den += __expf(gl[j] - gm);
        const float gw = 1.0f / den;
        float v0 = -INFINITY, v1 = -INFINITY; int i0 = 0, i1 = 0;
#pragma unroll
        for (int j = 0; j < 8; ++j) { const int cj = 4 + gi * 8 + j; const float v = (p0[cj] + p0[2048 + cj]) + (p0[4096 + cj] + p0[6144 + cj]) + a.b_re[gi * 8 + j];
            if (v > v0) { v1 = v0; i1 = i0; v0 = v; i0 = j; } else if (v > v1) { v1 = v; i1 = j; } }
        const float wa = 1.0f / (1.0f + __expf(v1 - v0)), wb = 1.0f - wa;
        const int ea = gi * 8 + i0, eb = gi * 8 + i1;
        const int ia = (int)__hip_atomic_fetch_add((unsigned*)(F.ctl + CW_CNT + 64 * ea), 1u, RLX_AGENT), ib = (int)__hip_atomic_fetch_add((unsigned*)(F.ctl + CW_CNT + 64 * eb), 1u, RLX_AGENT);
        int* ro = (int*)(ws + WS_ROUTE) + (row0 + rl) * 8;
        ro[0] = ea; ro[1] = eb; ((float*)ro)[2] = wa * gw; ((float*)ro)[3] = wb * gw; ro[4] = ia; ro[5] = ib; }
    __syncthreads();
}
__device__ __forceinline__ void moe_scatter(const Frame& F, const Args& a) {
    unsigned char* ws = a.ws;
    LAS int* off = (LAS int*)(F.lds);
    if (F.tid == 0) { int acc = 0;
        for (int e = 0; e < NEXP; ++e) { const int cnt = (int)__hip_atomic_load((unsigned*)(F.ctl + CW_CNT + 64 * e), RLX_AGENT); off[e] = acc; const int nt = (cnt + 255) >> 8;
            if (blockIdx.x == 0) { int* te = (int*)(ws + WS_TILEE); for (int t = 0; t < nt; ++t) te[(acc >> 8) + t] = e; }
            acc += nt << 8; }
        if (blockIdx.x == 0) __hip_atomic_store((unsigned*)(F.ctl + CW_NTILES), (unsigned)(acc >> 8), RLX_AGENT); }
    __syncthreads();
    const int gw = F.vcu * NWAVES + F.wave, NGW = F.G * NWAVES;
    const bf16* H2 = (const bf16*)(ws + WS_XN); bf16* H2S = (bf16*)(ws + WS_H2S);
    for (int m = gw; m < M_TOK; m += NGW) { const int* ro = (const int*)(ws + WS_ROUTE) + (size_t)m * 8;
        const int pa = off[ro[0]] + ro[4], pb = off[ro[1]] + ro[5];
        const v4u v0 = *((const v4u*)(H2 + (size_t)m * D) + F.lane), v1 = *((const v4u*)(H2 + (size_t)m * D) + 64 + F.lane);
        *((v4u*)(H2S + (size_t)pa * D) + F.lane) = v0; *((v4u*)(H2S + (size_t)pa * D) + 64 + F.lane) = v1;
        *((v4u*)(H2S + (size_t)pb * D) + F.lane) = v0; *((v4u*)(H2S + (size_t)pb * D) + 64 + F.lane) = v1;
        if (F.lane == 0) { int* po = (int*)(ws + WS_POS) + (size_t)m * 2; po[0] = pa; po[1] = pb; } }
    __syncthreads();
}
__device__ __forceinline__ void moe_combine(const Frame& F, const Args& a) {
    unsigned char* ws = a.ws;
    const int gw = F.vcu * NWAVES + F.wave, NGW = F.G * NWAVES, lane = F.lane;
    const bf16* SL = (const bf16*)(ws + WS_H2S); bf16* H3 = (bf16*)(ws + WS_XN); bf16* PB = (bf16*)(ws + WS_BC);
    for (int m = gw; m < M_TOK; m += NGW) { const int* ro = (const int*)(ws + WS_ROUTE) + (size_t)m * 8; const int* po = (const int*)(ws + WS_POS) + (size_t)m * 2;
#ifdef DEBUG_NO_MOE
        const float wa = 0.f, wb = 0.f; const int pa = 0, pb = 0; (void)ro; (void)po;
#else
        const float wa = ((const float*)ro)[2], wb = ((const float*)ro)[3]; const int pa = po[0], pb = po[1];
#endif
        GAS f32x4* xr = (GAS f32x4*)(a.out + (size_t)m * D) + lane; const GAS v2u* sa = (const GAS v2u*)(SL + (size_t)pa * D) + lane; const GAS v2u* sb = (const GAS v2u*)(SL + (size_t)pb * D) + lane;
        const GAS f32x4* wr = (const GAS f32x4*)a.ple_norm_w + lane;
        f32x4 v[4]; float s = 0.f;
#pragma unroll
        for (int j = 0; j < 4; ++j) { v[j] = xr[64 * j]; const v2u qa = sa[64 * j], qb = sb[64 * j];
            v[j].x += wa * bflo(qa.x) + wb * bflo(qb.x); v[j].y += wa * bfhi(qa.x) + wb * bfhi(qb.x); v[j].z += wa * bflo(qa.y) + wb * bflo(qb.y); v[j].w += wa * bfhi(qa.y) + wb * bfhi(qb.y);
            xr[64 * j] = v[j]; s += (v[j].x * v[j].x + v[j].y * v[j].y) + (v[j].z * v[j].z + v[j].w * v[j].w); }
        const float inv = 1.0f / sqrtf(wave_sum(s) * (1.f / D) + EPS);
#pragma unroll
        for (int j = 0; j < 4; ++j) { const f32x4 ww = wr[64 * j]; v2u o; o.x = pk2(v[j].x * inv * ww.x, v[j].y * inv * ww.y); o.y = pk2(v[j].z * inv * ww.z, v[j].w * inv * ww.w); ((GAS v2u*)(H3 + (size_t)m * D) + lane)[64 * j] = o; }
        { const f32x4 pv = *((const GAS f32x4*)(a.p + (size_t)m * 256) + lane); v2u o; o.x = pk2(pv.x, pv.y); o.y = pk2(pv.z, pv.w); *((GAS v2u*)(PB + (size_t)m * 256) + lane) = o; } }
}
__device__ __forceinline__ void final_norm(const Frame& F, const Args& a) {
    const int gw = F.vcu * NWAVES + F.wave, NGW = F.G * NWAVES, lane = F.lane;
    for (int m = gw; m < M_TOK; m += NGW) { GAS f32x4* xr = (GAS f32x4*)(a.out + (size_t)m * D) + lane; const GAS f32x4* wr = (const GAS f32x4*)a.final_norm_w + lane;
        f32x4 v[4]; float s = 0.f;
#pragma unroll
        for (int j = 0; j < 4; ++j) { v[j] = xr[64 * j];
#ifdef DEBUG_SANITIZE
            for (int q = 0; q < 4; ++q) if (!(__builtin_fabsf(v[j][q]) < 1e30f)) v[j][q] = 0.f;
#endif
            s += (v[j].x * v[j].x + v[j].y * v[j].y) + (v[j].z * v[j].z + v[j].w * v[j].w); }
        const float inv = 1.0f / sqrtf(wave_sum(s) * (1.f / D) + EPS);
#pragma unroll
        for (int j = 0; j < 4; ++j) { const f32x4 ww = wr[64 * j]; xr[64 * j] = (f32x4){v[j].x * inv * ww.x, v[j].y * inv * ww.y, v[j].z * inv * ww.z, v[j].w * inv * ww.w}; } }
}

__global__ void __launch_bounds__(NWAVES * 64, 2) fwd_kernel(Args args) {
    extern __shared__ __attribute__((aligned(16))) unsigned char lds[];
    Frame F;
    F.lds = (LAS unsigned char*)lds;
    F.MISC = (volatile LAS unsigned*)(F.lds + MISC_OFF);
#define REFRAME() do { F.tid = opaque_tid(); F.lane = F.tid & 63; F.wave = __builtin_amdgcn_readfirstlane(F.tid >> 6); } while (0)
    REFRAME();
    F.G = gridDim.x; { const int bx = blockIdx.x; F.vcu = (F.G % 8 == 0) ? (bx % 8) * (F.G / 8) + bx / 8 : bx; }
    unsigned char* ws = args.ws;
    F.ctl = (gu32*)(ws + WS_CTL);
    for (int u = F.tid; u < (LDS_BYTES - LDSCTL_OFF) / 4; u += NWAVES * 64) ((LAS unsigned*)(F.lds + LDSCTL_OFF))[u] = 0u;
    __syncthreads();
    const int lo = args.ph_lo, hi = args.ph_hi;
    const bool multi = (hi - lo) > 1;
    XcdBarrier bar; bar.bar = (unsigned*)(F.ctl + CW_BAR); bar.x = 0; bar.st = nullptr;
    if (multi) bar = xcd_barrier_post((unsigned*)(F.ctl + CW_BAR), F.MISC + 8);
#ifndef PHASE_MASK
#define PHASE_MASK 0x7fff
#endif
#define IN(k) (((PHASE_MASK >> (k)) & 1) && lo <= (k) && (k) < hi)
#define SEAM(k) do { if (IN(k) && IN((k) + 1)) xcd_barrier(bar); } while (0)

    if (IN(0)) { REFRAME(); p0_prologue(F, args); } SEAM(0);
    if (IN(1)) {
        pg8::Gemm g{(const pg8::bf16_t*)(ws + WS_XN), (const pg8::bf16_t*)(ws + WS_WIN), M_TOK, NIN, D}; pg8::StaticOrder S; S.init(M_TOK, NIN, F.G, (int)blockIdx.x);
        pg8::EpiInProj E{(pg8::bf16_t*)(ws + WS_Z), (pg8::bf16_t*)args.out, (pg8::bf16_t*)(ws + WS_BC), (float*)(ws + WS_DT), (const float*)(ws + WS_ROPE), args.dt_bias, attn_body::C2};
        pg8::gemm_phase<pg8::EpiInProj, pg8::StaticOrder, true, true>(F.lds + RING_OFF, g, S, E);
    } SEAM(1);
    if (IN(2)) { REFRAME(); for (int it = F.vcu; it < 640; it += F.G) { if (it < 512) ssd_states_unit(F, args, it); else kmean_unit(F, args, it - 512); } } SEAM(2);
    if (IN(3)) { REFRAME(); ssd_scan(F, args); } SEAM(3);
    if (IN(4)) { REFRAME(); for (int it = F.vcu; it < 512; it += F.G) ssd_out_unit(F, args, it); } SEAM(4);
    if (IN(5)) {
        const attn_body::AttnTensors AT{(const attn_body::bf16*)(ws + WS_Q), (const attn_body::bf16*)(ws + WS_K), (const attn_body::bf16*)(ws + WS_V), (attn_body::bf16*)(ws + WS_Q), (const attn_body::bf16*)(ws + WS_KM)};
        const attn_body::StaticOrder S((int)F.G, (int)blockIdx.x);
        attn_body::attn_phase<attn_body::StaticOrder>((char*)lds + RING_OFF, AT, S);
    } SEAM(5);
    if (IN(6)) {
        pg8::Gemm g{(const pg8::bf16_t*)(ws + WS_Z), (const pg8::bf16_t*)(ws + WS_WSA), M_TOK, D, D}; pg8::DualOrder S; S.init(M_TOK, D, F.G, (int)blockIdx.x); S.a_off = (int)((WS_Q - WS_Z) / (512 * 1024)); S.b_off = 4;
        pg8::EpiMerge E{(pg8::bf16_t*)(ws + WS_XS), (const pg8::bf16_t*)args.out, (const pg8::bf16_t*)args.out + (size_t)M_TOK * 1024};
        pg8::gemm_phase<pg8::EpiMerge, pg8::DualOrder, true, true>(F.lds + RING_OFF, g, S, E);
    } SEAM(6);
    if (IN(7)) {
        pg8::Gemm g{(const pg8::bf16_t*)(ws + WS_XS), (const pg8::bf16_t*)(ws + WS_WO), M_TOK, D, D}; pg8::StaticOrder S; S.init(M_TOK, D, F.G, (int)blockIdx.x);
        pg8::EpiResid E{args.out, args.x};
        pg8::gemm_phase<pg8::EpiResid, pg8::StaticOrder, true, true>(F.lds + RING_OFF, g, S, E);
    } SEAM(7);
    if (IN(8)) { REFRAME(); for (int it = F.vcu; it < M_TOK / 32; it += F.G) moe_route_block(F, args, it); } SEAM(8);
    if (IN(9)) { REFRAME(); moe_scatter(F, args); } SEAM(9);
    if (IN(10)) {
        const int ntiles = __builtin_amdgcn_readfirstlane((int)__hip_atomic_load((unsigned*)(F.ctl + CW_NTILES), RLX_AGENT));
        pg8::Gemm g{(const pg8::bf16_t*)(ws + WS_H2S), (const pg8::bf16_t*)(ws + WS_WGU), MOE_ROWS, 512, D}; pg8::MoeOrder<2> S{(const int*)(ws + WS_TILEE), ntiles, F.G, F.vcu};
        pg8::EpiHid E{(pg8::bf16_t*)(ws + WS_HID)};
        pg8::gemm_phase<pg8::EpiHid, pg8::MoeOrder<2>, true, true>(F.lds + RING_OFF, g, S, E);
    } SEAM(10);
    if (IN(11)) {
        const int ntiles = __builtin_amdgcn_readfirstlane((int)__hip_atomic_load((unsigned*)(F.ctl + CW_NTILES), RLX_AGENT));
        pg8::Gemm g{(const pg8::bf16_t*)(ws + WS_HID), (const pg8::bf16_t*)(ws + WS_WD), MOE_ROWS, D, 256}; pg8::MoeOrder<4> S{(const int*)(ws + WS_TILEE), ntiles, F.G, F.vcu};
        pg8::EpiPlain E{(pg8::bf16_t*)(ws + WS_H2S), 1024};
        pg8::gemm_phase<pg8::EpiPlain, pg8::MoeOrder<4>, true, true>(F.lds + RING_OFF, g, S, E);
    } SEAM(11);
    if (IN(12)) { REFRAME(); moe_combine(F, args); } SEAM(12);
    if (IN(13)) {
        { pg8::Gemm g{(const pg8::bf16_t*)(ws + WS_BC), (const pg8::bf16_t*)(ws + WS_WPLE), M_TOK, D, 256}; pg8::StaticOrder S; S.init(M_TOK, D, F.G, (int)blockIdx.x);
          pg8::EpiPlain E{(pg8::bf16_t*)(ws + WS_PE), 1024};
          pg8::gemm_phase<pg8::EpiPlain, pg8::StaticOrder, true, true>(F.lds + RING_OFF, g, S, E); }
        __syncthreads();
        { pg8::Gemm g{(const pg8::bf16_t*)(ws + WS_XN), (const pg8::bf16_t*)(ws + WS_WPG), M_TOK, D, D}; pg8::StaticOrder S; S.init(M_TOK, D, F.G, (int)blockIdx.x);
          pg8::EpiPle E{args.out, (const pg8::bf16_t*)(ws + WS_PE)};
          pg8::gemm_phase<pg8::EpiPle, pg8::StaticOrder, true, true>(F.lds + RING_OFF, g, S, E); }
    } SEAM(13);
    if (IN(14)) { REFRAME(); final_norm(F, args); }
#undef IN
#undef SEAM
}

extern "C" void kernel_launch(void* const* d_in, const int* in_sizes, int n_in, void* d_out, int out_size, void* d_ws, size_t ws_size, hipStream_t stream) {
    static int grid = 0;
    if (grid == 0) {
        if (n_in != 26 || in_sizes[0] != M_TOK * D || out_size != M_TOK * D || ws_size < WS_END) { fprintf(stderr, "kernel_launch: unexpected shapes (n_in %d, in0 %d, out %d, ws %zu); nothing launched\n", n_in, n_in > 0 ? in_sizes[0] : -1, out_size, ws_size); grid = -1; return; }
        int dev = 0, cus = 0, per_cu = 0;
        if (hipGetDevice(&dev) != hipSuccess || hipDeviceGetAttribute(&cus, hipDeviceAttributeMultiprocessorCount, dev) != hipSuccess) { grid = -1; return; }
        if (hipFuncSetAttribute((const void*)fwd_kernel, hipFuncAttributeMaxDynamicSharedMemorySize, LDS_BYTES) != hipSuccess) { fprintf(stderr, "kernel_launch: hipFuncSetAttribute failed\n"); grid = -1; return; }
        if (hipOccupancyMaxActiveBlocksPerMultiprocessor(&per_cu, (const void*)fwd_kernel, NWAVES * 64, LDS_BYTES) != hipSuccess || per_cu < 1) fprintf(stderr, "kernel_launch: occupancy query reports %d\n", per_cu);
        (void)hipGetLastError();
        grid = cus;
    }
    if (grid < 0) return;
    (void)hipMemsetAsync((char*)d_ws + WS_CTL, 0, CTL_ZERO_BYTES, stream);
    Args a{};
    a.x = (const float*)d_in[0]; a.p = (const float*)d_in[1]; a.positions = (const int*)d_in[2]; a.attn_norm_w = (const float*)d_in[3]; a.w_in = (const float*)d_in[4];
    a.conv_w = (const float*)d_in[5]; a.conv_b = (const float*)d_in[6]; a.dt_bias = (const float*)d_in[7]; a.a_log = (const float*)d_in[8]; a.d_skip = (const float*)d_in[9];
    a.ssd_norm_w = (const float*)d_in[10]; a.w_ssd_out = (const float*)d_in[11]; a.w_attn_out = (const float*)d_in[12]; a.w_out = (const float*)d_in[13]; a.moe_norm_w = (const float*)d_in[14];
    a.w_rg = (const float*)d_in[15]; a.b_rg = (const float*)d_in[16]; a.w_re = (const float*)d_in[17]; a.b_re = (const float*)d_in[18]; a.w_eg = (const float*)d_in[19]; a.w_eu = (const float*)d_in[20];
    a.w_ed = (const float*)d_in[21]; a.ple_norm_w = (const float*)d_in[22]; a.w_ple = (const float*)d_in[23]; a.w_pg = (const float*)d_in[24]; a.final_norm_w = (const float*)d_in[25];
    a.out = (float*)d_out; a.ws = (unsigned char*)d_ws;
#if MK_ONE_LAUNCH
    a.ph_lo = 0; a.ph_hi = NPHASE;
    hipLaunchKernelGGL(fwd_kernel, dim3(grid), dim3(NWAVES * 64), LDS_BYTES, stream, a);
#else
    for (int ph = 0; ph < NPHASE; ++ph) { a.ph_lo = ph; a.ph_hi = ph + 1; hipLaunchKernelGGL(fwd_kernel, dim3(grid), dim3(NWAVES * 64), LDS_BYTES, stream, a); }
#endif
}
```
